# Optimizing an MI355X kernel written in HIP

```python
import math
import jax, jax.numpy as jnp
from jax import lax
import numpy as np

D_MODEL = 1024
BATCH = 4
SEQ = 4096
DEPTH = 4

GRID_W = 64
CTX_LEN = 256
N_MIXERS = 4
Q_BLOCK = 128
CHUNK = 64
ROPE_THETA = 10000.0
NORM_EPS = 1e-6
N_MOD = 9
D_FF = 2816

DIFF_HEADS = 8
DIFF_HEAD_DIM = D_MODEL // DIFF_HEADS // 2

RET_HEADS = 4
RET_KEY_DIM = D_MODEL // RET_HEADS
RET_VAL_DIM = 2 * D_MODEL // RET_HEADS

HGRN_EXPAND = 128
HGRN_HEADS = D_MODEL // HGRN_EXPAND
HGRN_KEY_DIM = HGRN_EXPAND
HGRN_VAL_DIM = D_MODEL // HGRN_HEADS

GQA_HEAD_DIM = 128
GQA_Q_HEADS = D_MODEL // GQA_HEAD_DIM
GQA_KV_HEADS = 2
GQA_GROUP = GQA_Q_HEADS // GQA_KV_HEADS

kernel_name = "hybrid_interleaved_diffusion_trunk"


def _rms(x, eps=NORM_EPS):
    xf = x.astype(jnp.float32)
    return (xf * lax.rsqrt(jnp.mean(xf * xf, axis=-1, keepdims=True) + eps)).astype(x.dtype)


def _modulate(h, shift, scale):
    return _rms(h) * (1.0 + scale) + shift


def _split_mod(v):
    v = v.reshape(*v.shape[:-1], N_MOD, 1, D_MODEL)
    return [v[..., k, :, :] for k in range(N_MOD)]


def _swiglu(h, w13, w2):
    a, b = jnp.split(h @ w13, 2, axis=-1)
    return (jax.nn.silu(a) * b) @ w2


def _axial_rope_tables(n_tokens, head_dim):
    rows = n_tokens // GRID_W
    row = jnp.repeat(jnp.arange(rows, dtype=jnp.float32), GRID_W)
    col = jnp.tile(jnp.arange(GRID_W, dtype=jnp.float32), rows)
    nq = head_dim // 4
    inv = ROPE_THETA ** (-jnp.arange(nq, dtype=jnp.float32) * 2.0 / (head_dim // 2))
    ang = jnp.stack([row[:, None] * inv, col[:, None] * inv], axis=1)
    return jnp.cos(ang), jnp.sin(ang)


def _apply_rope(x, cos, sin):
    shp = x.shape
    xr = x.reshape(*shp[:-1], 2, 2, shp[-1] // 4)
    x1, x2 = xr[..., 0, :], xr[..., 1, :]
    extra = len(shp) - 3
    c = cos.reshape(cos.shape[0], *([1] * extra), 2, -1)
    s = sin.reshape(sin.shape[0], *([1] * extra), 2, -1)
    out = jnp.stack([x1 * c - x2 * s, x2 * c + x1 * s], axis=-2)
    return out.reshape(shp).astype(x.dtype)


def _to_blocks(t):
    B, T = t.shape[:2]
    return jnp.moveaxis(t.reshape(B, T // Q_BLOCK, Q_BLOCK, *t.shape[2:]), 1, 0)


def _from_blocks(t):
    nb, B, qb = t.shape[:3]
    return jnp.moveaxis(t, 0, 1).reshape(B, nb * qb, *t.shape[3:])


def _chunk_gla(q, k, v, log_a, s0):
    B, T, H, _ = q.shape
    n = T // CHUNK

    def chunks(t):
        return jnp.moveaxis(t.astype(jnp.float32).reshape(B, n, CHUNK, *t.shape[2:]), 1, 0)

    causal = jnp.tril(jnp.ones((CHUNK, CHUNK), dtype=bool))

    def step(state, inp):
        qc, kc, vc, lc = inp
        b = jnp.cumsum(lc, axis=1)
        b_last = b[:, -1]
        q_dec = qc * jnp.exp(b)
        k_dec = kc * jnp.exp(-b)
        att = jnp.where(causal, jnp.einsum('bchk,bshk->bhcs', q_dec, k_dec), 0.0)
        o = (jnp.einsum('bchk,bhkv->bchv', q_dec, state)
             + jnp.einsum('bhcs,bshv->bchv', att, vc))
        state = (jnp.exp(b_last)[..., None] * state
                 + jnp.einsum('bshk,bshv->bhkv', kc * jnp.exp(b_last[:, None] - b), vc))
        return state, o

    state, o = lax.scan(step, s0, (chunks(q), chunks(k), chunks(v), chunks(log_a)))
    o = jnp.moveaxis(o, 0, 1).reshape(B, T, H, v.shape[-1]).astype(v.dtype)
    return o, state


def _bidir_scan(q_c, v_c, dirs_c, q_l, v_l, dirs_l):
    B, _, H, dk = q_c.shape
    s0 = jnp.zeros((B, H, dk, v_c.shape[-1]), jnp.float32)
    rev = lambda t: t[:, ::-1]
    (kcf, lcf), (kcb, lcb) = dirs_c
    (klf, llf), (klb, llb) = dirs_l
    oc_f, s_f = _chunk_gla(q_c, kcf, v_c, lcf, s0)
    oc_b, s_b = _chunk_gla(rev(q_c), rev(kcb), rev(v_c), rev(lcb), s0)
    ol_f, _ = _chunk_gla(q_l, klf, v_l, llf, s_f)
    ol_b, _ = _chunk_gla(rev(q_l), rev(klb), rev(v_l), rev(llb), s_b)
    return oc_f + rev(oc_b), ol_f + rev(ol_b)


def _diff_attention(h_lat, h_ctx, w_in, w_out, lam, subln_g, layer_idx, need_ctx):
    H, d = DIFF_HEADS, DIFF_HEAD_DIM
    lam_init = 0.8 - 0.6 * math.exp(-0.3 * layer_idx)
    l32 = lam.astype(jnp.float32)
    lam_full = jnp.exp(jnp.sum(l32[0] * l32[1])) - jnp.exp(jnp.sum(l32[2] * l32[3])) + lam_init
    cos, sin = _axial_rope_tables(h_lat.shape[1], d)

    def project(h, rotate):
        B, T, _ = h.shape
        q, k, v = jnp.split(h @ w_in, 3, axis=-1)
        q = q.reshape(B, T, H, 2, d) * (d ** -0.5)
        k = k.reshape(B, T, H, 2, d)
        if rotate:
            q, k = _apply_rope(q, cos, sin), _apply_rope(k, cos, sin)
        return q, k, v.reshape(B, T, H, 2 * d)

    def attend(q, k, v):
        s = jnp.einsum('bqhjd,bshjd->bhjqs', q, k).astype(jnp.float32)
        p = jax.nn.softmax(s, axis=-1)
        a = (p[:, :, 0] - lam_full * p[:, :, 1]).astype(v.dtype)
        o = jnp.einsum('bhqs,bshe->bqhe', a, v)
        return _rms(o) * subln_g * (1.0 - lam_init)

    def out_proj(o):
        B, T = o.shape[:2]
        return o.reshape(B, T, D_MODEL) @ w_out

    ql, kl, vl = project(h_lat, True)
    qc, kc, vc = project(h_ctx, False)
    k_all = jnp.concatenate([kc, kl], axis=1)
    v_all = jnp.concatenate([vc, vl], axis=1)
    o_lat = _from_blocks(lax.map(lambda qb: attend(qb, k_all, v_all), _to_blocks(ql)))
    o_ctx = out_proj(attend(qc, kc, vc)) if need_ctx else None
    return out_proj(o_lat), o_ctx


def _retention(h_lat, h_ctx, w_in, w_out, decay_exp, need_ctx):
    H, dk, dv = RET_HEADS, RET_KEY_DIM, RET_VAL_DIM
    D = D_MODEL
    log_gamma = jnp.log1p(-jnp.exp2(-decay_exp.astype(jnp.float32)))
    cos, sin = _axial_rope_tables(h_lat.shape[1], dk)

    def project(h, rotate):
        B, T, _ = h.shape
        q, k, v, g = jnp.split(h @ w_in, [D, 2 * D, 4 * D], axis=-1)
        q = q.reshape(B, T, H, dk)
        k = k.reshape(B, T, H, dk) * (dk ** -0.5)
        if rotate:
            q, k = _apply_rope(q, cos, sin), _apply_rope(k, cos, sin)
        dirs = tuple((k, jnp.broadcast_to(log_gamma[r][None, None, :, None], (B, T, H, 1)))
                     for r in range(2))
        return q, v.reshape(B, T, H, dv), dirs, g

    ql, vl, dl, gl = project(h_lat, True)
    qc, vc, dc, gc = project(h_ctx, False)
    o_ctx, o_lat = _bidir_scan(qc, vc, dc, ql, vl, dl)

    def readout(o, g):
        B, T = o.shape[:2]
        return (jax.nn.silu(g) * _rms(o).reshape(B, T, 2 * D)) @ w_out

    return readout(o_lat, gl), (readout(o_ctx, gc) if need_ctx else None)


def _hgrn2(h_lat, h_ctx, w_in, w_out, lb_logits, norm_g, layer_idx, need_ctx):
    H, dk, dv = HGRN_HEADS, HGRN_KEY_DIM, HGRN_VAL_DIM
    p = jax.nn.softmax(lb_logits.astype(jnp.float32), axis=0)
    lb = (jnp.cumsum(p, axis=0) - p[0])[layer_idx].reshape(H, dk)

    def project(h):
        B, T, _ = h.shape
        q, i, g, zf, zb = jnp.split(h @ w_in, 5, axis=-1)
        q = jax.nn.silu(q).reshape(B, T, H, dk)

        def gate(z):
            f = lb + (1.0 - lb) * jax.nn.sigmoid(z.astype(jnp.float32).reshape(B, T, H, dk))
            return (1.0 - f, jnp.log(f))

        return q, i.reshape(B, T, H, dv), (gate(zf), gate(zb)), g

    ql, il, dl, gl = project(h_lat)
    qc, ic, dc, gc = project(h_ctx)
    o_ctx, o_lat = _bidir_scan(qc, ic, dc, ql, il, dl)

    def readout(o, g):
        B, T = o.shape[:2]
        return ((_rms(o) * norm_g).reshape(B, T, D_MODEL) * jax.nn.silu(g)) @ w_out

    return readout(o_lat, gl), (readout(o_ctx, gc) if need_ctx else None)


def _gqa(h_lat, h_ctx, w_in, w_out, q_g, k_g, need_ctx):
    Hk, G, d = GQA_KV_HEADS, GQA_GROUP, GQA_HEAD_DIM
    cos, sin = _axial_rope_tables(h_lat.shape[1], d)

    def project(h, rotate):
        B, T, _ = h.shape
        q, k, v = jnp.split(h @ w_in, [D_MODEL, D_MODEL + Hk * d], axis=-1)
        q = _rms(q.reshape(B, T, Hk, G, d)) * q_g * (d ** -0.5)
        k = _rms(k.reshape(B, T, Hk, d)) * k_g
        if rotate:
            q, k = _apply_rope(q, cos, sin), _apply_rope(k, cos, sin)
        return q, k, v.reshape(B, T, Hk, d)

    def attend(q, k, v):
        s = jnp.einsum('bqhgd,bshd->bhgqs', q, k).astype(jnp.float32)
        pr = jax.nn.softmax(s, axis=-1).astype(v.dtype)
        return jnp.einsum('bhgqs,bshd->bqhgd', pr, v)

    def out_proj(o):
        B, T = o.shape[:2]
        return o.reshape(B, T, D_MODEL) @ w_out

    ql, kl, vl = project(h_lat, True)
    qc, kc, vc = project(h_ctx, False)
    k_all = jnp.concatenate([kc, kl], axis=1)
    v_all = jnp.concatenate([vc, vl], axis=1)
    o_lat = _from_blocks(lax.map(lambda qb: attend(qb, k_all, v_all), _to_blocks(ql)))
    o_ctx = out_proj(attend(qc, kc, vc)) if need_ctx else None
    return out_proj(o_lat), o_ctx


def setup_inputs(seed: int = 0) -> dict:
    key = jax.random.key(seed)
    ks = jax.random.split(key, 32)
    D, F = D_MODEL, D_FF
    cnt = [len(range(m, DEPTH, N_MIXERS)) for m in range(N_MIXERS)]
    nA, nB, nC, nD = cnt

    def nrm(i, shape, scale):
        return jax.random.normal(ks[i], shape, jnp.float32) * scale

    gqa_in = D + 2 * GQA_KV_HEADS * GQA_HEAD_DIM
    return {
        "x": nrm(0, (BATCH, SEQ, D), 1.0),
        "c": nrm(1, (BATCH, D), 1.0),
        "ctx": nrm(2, (BATCH, CTX_LEN, D), 1.0),
        "c_ctx": nrm(3, (D,), 1.0),
        "mod_w": nrm(4, (DEPTH, D, N_MOD * D), 0.5 * D ** -0.5),
        "mod_b": nrm(5, (DEPTH, N_MOD * D), 0.02),
        "ffn1_w13": nrm(6, (DEPTH, D, 2 * F), D ** -0.5),
        "ffn1_w2": nrm(7, (DEPTH, F, D), F ** -0.5),
        "ffn2_w13": nrm(8, (DEPTH, D, 2 * F), D ** -0.5),
        "ffn2_w2": nrm(9, (DEPTH, F, D), F ** -0.5),
        "diff_w_in": nrm(10, (nA, D, 3 * D), D ** -0.5),
        "diff_w_out": nrm(11, (nA, D, D), D ** -0.5),
        "diff_lambda": nrm(12, (nA, 4, DIFF_HEAD_DIM), 0.1),
        "diff_subln_g": 1.0 + nrm(13, (nA, 2 * DIFF_HEAD_DIM), 0.02),
        "ret_w_in": nrm(14, (nB, D, 6 * D), D ** -0.5),
        "ret_w_out": nrm(15, (nB, 2 * D, D), (2 * D) ** -0.5),
        "ret_decay_exp": 5.0 + jnp.arange(RET_HEADS, dtype=jnp.float32) + nrm(16, (nB, 2, RET_HEADS), 0.1),
        "hgrn_w_in": nrm(17, (nC, D, 5 * D), D ** -0.5),
        "hgrn_w_out": nrm(18, (nC, D, D), D ** -0.5),
        "hgrn_lb_logits": nrm(19, (DEPTH, D), 0.1),
        "hgrn_norm_g": 1.0 + nrm(20, (nC, HGRN_VAL_DIM), 0.02),
        "gqa_w_in": nrm(21, (nD, D, gqa_in), D ** -0.5),
        "gqa_w_out": nrm(22, (nD, D, D), D ** -0.5),
        "gqa_q_norm_g": 1.0 + nrm(23, (nD, GQA_HEAD_DIM), 0.02),
        "gqa_k_norm_g": 1.0 + nrm(24, (nD, GQA_HEAD_DIM), 0.02),
        "final_norm_g": 1.0 + nrm(25, (D,), 0.02),
    }


def reference(x, c, ctx, c_ctx, mod_w, mod_b, ffn1_w13, ffn1_w2, ffn2_w13, ffn2_w2,
              diff_w_in, diff_w_out, diff_lambda, diff_subln_g,
              ret_w_in, ret_w_out, ret_decay_exp,
              hgrn_w_in, hgrn_w_out, hgrn_lb_logits, hgrn_norm_g,
              gqa_w_in, gqa_w_out, gqa_q_norm_g, gqa_k_norm_g,
              final_norm_g):
    cond_lat = jax.nn.silu(c)
    cond_ctx = jax.nn.silu(c_ctx)
    h, hc = x, ctx
    for i in range(DEPTH):
        kind, j = i % N_MIXERS, i // N_MIXERS
        need_ctx = i < DEPTH - 1
        ml = _split_mod(cond_lat @ mod_w[i] + mod_b[i])
        mc = _split_mod(cond_ctx @ mod_w[i] + mod_b[i])

        h = h + 0.5 * ml[2] * _swiglu(_modulate(h, ml[0], ml[1]), ffn1_w13[i], ffn1_w2[i])
        hc = hc + 0.5 * mc[2] * _swiglu(_modulate(hc, mc[0], mc[1]), ffn1_w13[i], ffn1_w2[i])

        a_l = _modulate(h, ml[3], ml[4])
        a_c = _modulate(hc, mc[3], mc[4])
        if kind == 0:
            o_l, o_c = _diff_attention(a_l, a_c, diff_w_in[j], diff_w_out[j], diff_lambda[j],
                                       diff_subln_g[j], i, need_ctx)
        elif kind == 1:
            o_l, o_c = _retention(a_l, a_c, ret_w_in[j], ret_w_out[j], ret_decay_exp[j], need_ctx)
        elif kind == 2:
            o_l, o_c = _hgrn2(a_l, a_c, hgrn_w_in[j], hgrn_w_out[j], hgrn_lb_logits,
                              hgrn_norm_g[j], i, need_ctx)
        else:
            o_l, o_c = _gqa(a_l, a_c, gqa_w_in[j], gqa_w_out[j], gqa_q_norm_g[j],
                            gqa_k_norm_g[j], need_ctx)
        h = h + ml[5] * o_l

        h = h + 0.5 * ml[8] * _swiglu(_modulate(h, ml[6], ml[7]), ffn2_w13[i], ffn2_w2[i])
        if need_ctx:
            hc = hc + mc[5] * o_c
            hc = hc + 0.5 * mc[8] * _swiglu(_modulate(hc, mc[6], mc[7]), ffn2_w13[i], ffn2_w2[i])
    return _rms(h) * final_norm_g
```

```cpp
#include <hip/hip_runtime.h>
#include <hip/hip_cooperative_groups.h>
#include <cstdio>
#include <cstdint>
namespace cg = cooperative_groups;

#define LAS __attribute__((address_space(3)))
#define GAS __attribute__((address_space(1)))
typedef unsigned short bf16_t;
typedef short bf16x8 __attribute__((ext_vector_type(8)));
typedef short s16x4 __attribute__((ext_vector_type(4)));
typedef float f32x4 __attribute__((ext_vector_type(4)));
typedef float f32x2 __attribute__((ext_vector_type(2)));
typedef float f32x16 __attribute__((ext_vector_type(16)));
typedef unsigned u32x4 __attribute__((ext_vector_type(4)));
typedef unsigned u32x2 __attribute__((ext_vector_type(2)));

constexpr int NB = 4, SEQ = 4096, CTXL = 256, TB = SEQ + CTXL  , M = NB * TB  , DM = 1024, FF = 2816, NMOD = 9 * DM;
constexpr float EPS = 1e-6f;

constexpr size_t al256(size_t x) { return (x + 255) / 256 * 256; }
constexpr size_t WS_H = 0;
constexpr size_t WS_XN = WS_H + (size_t)M * DM * 4;
constexpr size_t WS_MOD = WS_XN + (size_t)M * DM * 2;
constexpr size_t WS_MODP = WS_MOD + al256((size_t)4 * 5 * NMOD * 4);
constexpr size_t WS_LBV = WS_MODP + al256((size_t)8 * 4 * 5 * NMOD * 4);
constexpr size_t WS_ROPE = WS_LBV + 4096;
constexpr size_t ROPE16 = 0, ROPE32 = 64 * 16 * 2, ROPE64 = ROPE32 + 64 * 32 * 2;
constexpr size_t WS_BAR = WS_ROPE + 65536 - 256;
constexpr size_t WS_XB = WS_ROPE + 65536;
constexpr size_t WS_W13A = WS_XB + 16384;
constexpr size_t WS_W2A = WS_W13A + (size_t)2 * FF * DM * 2;
constexpr size_t WS_W13B = WS_W2A + (size_t)FF * DM * 2;
constexpr size_t WS_W2B = WS_W13B + (size_t)2 * FF * DM * 2;
constexpr size_t WS_WIN = WS_W2B + (size_t)FF * DM * 2;
constexpr size_t WS_WOUT = WS_WIN + (size_t)6144 * DM * 2;
constexpr size_t WS_BIG = WS_WOUT + (size_t)2048 * DM * 2;
constexpr size_t U1 = (size_t)M * DM * 2;
constexpr size_t WS_END = WS_BIG + 10 * U1;

typedef __bf16 bf16x2_t __attribute__((ext_vector_type(2)));
__device__ __forceinline__ unsigned cvt_pk_bf16(float lo, float hi) { const f32x2 v = {lo, hi}; const bf16x2_t b = __builtin_convertvector(v, bf16x2_t); return __builtin_bit_cast(unsigned, b); }
__device__ __forceinline__ bf16_t f2bf(float x) { return (bf16_t)(cvt_pk_bf16(x, x) & 0xffffu); }
__device__ __forceinline__ float bf2f(bf16_t v) { return __uint_as_float((unsigned)v << 16); }
__device__ __forceinline__ float siluf(float x) { return x * __builtin_amdgcn_rcpf(1.f + __expf(-x)); }
__device__ __forceinline__ float wave_sum(float v) {
#pragma unroll
    for (int o = 1; o < 64; o <<= 1) v += __shfl_xor(v, o);
    return v;
}
__device__ __forceinline__ u32x4 pack8(const float* v) { u32x4 w; w.x = cvt_pk_bf16(v[0], v[1]); w.y = cvt_pk_bf16(v[2], v[3]); w.z = cvt_pk_bf16(v[4], v[5]); w.w = cvt_pk_bf16(v[6], v[7]); return w; }

namespace pg8 {
constexpr int BM = 256, BK = 64, HALF = 128, HTB = HALF * BK * 2, STAGE_BYTES = 8 * HTB, NXCD = 8, WGM = 8;
__host__ __device__ __forceinline__ int lds_byte(int r, int c) { const int st = (r >> 4) * 2 + (c >> 5), rr = r & 15, cc = c & 31, ob = rr * 64 + cc * 2; return st * 1024 + (ob ^ (((ob >> 9) & 1) << 5)); }
__host__ __device__ __forceinline__ void stage_rc(int b, int& R, int& C) { const int st = b / 1024, sb = b % 1024, swz = sb ^ (((sb >> 9) & 1) << 5); R = (st >> 1) * 16 + swz / 64; C = (st & 1) * 32 + (swz % 64) / 2; }
__host__ __device__ __forceinline__ int perm32(int rho) { const int n = rho >> 4, i = rho & 15; return 8 * (i >> 2) + 4 * n + (i & 3); }
struct Unit { int pm, pn, kb; };
struct Gemm { const bf16_t* A; const bf16_t* Bt; int K, nt; };
struct Order {
    int nM, nN, nwg, G, c, mode, nsplit;
    __device__ void init(int nM_, int nN_, int G_, int c_, int mode_, int nsplit_) { nM = nM_; nN = nN_; nwg = mode_ == 2 ? 16 * nsplit_ : nM * nN; G = G_; c = c_; mode = mode_; nsplit = nsplit_; }
    __device__ bool next(int i, Unit& u) const {
        const long L = (long)i * G + c; if (L >= nwg) return false;
        if (mode == 2) { const int sp = (int)L % nsplit, t = (int)L / nsplit; u.pn = t & 3; u.pm = 17 * (t >> 2); u.kb = sp * 512; return true; }
        int wgid = (int)L; { const int q = nwg / NXCD, r = nwg % NXCD, xcd = wgid % NXCD, off = wgid / NXCD; wgid = (xcd < r ? xcd * (q + 1) : r * (q + 1) + (xcd - r) * q) + off; }
        const int nig = WGM * nN, gid = wgid / nig, fm = gid * WGM, gsz = (nM - fm) < WGM ? (nM - fm) : WGM;
        u.pm = fm + ((wgid % nig) % gsz); u.pn = (wgid % nig) / gsz; u.kb = 0;
        if (mode == 1) u.pm = u.pm + u.pm / 16 + 1;
        return true;
    }
};

enum { K_SWIGLU = 0, K_RESID = 1, K_DIFF = 2, K_RET = 3, K_HGRN = 4, K_GQA = 5, K_PART = 6 };
struct EpiAll {
    static constexpr bool PERM = true;
    int kind, aux;
    unsigned char* ws;
    __device__ __forceinline__ void plain(const f32x4 (&acc)[2][2][4][2], int row0, int wc, int fq, bf16_t* dst, int ld, int colbase, int act) const {
#pragma unroll
        for (int ai = 0; ai < 2; ++ai)
#pragma unroll
            for (int m = 0; m < 4; ++m) { bf16_t* rp = dst + (size_t)(row0 + ai * 128 + m * 16) * ld + colbase + wc * 32 + 8 * fq;
#pragma unroll
                for (int bj = 0; bj < 2; ++bj) { float v[8];
#pragma unroll
                    for (int e = 0; e < 8; ++e) { float x = acc[ai][bj][m][e >> 2][e & 3]; v[e] = act ? siluf(x) : x; }
                    *(u32x4*)(rp + bj * 128) = pack8(v); }
                asm volatile("" ::: "memory"); }
    }
    template <int NQ> __device__ __forceinline__ void roped(const float* rope, const f32x4 (&acc)[2][2][4][2], int row0, bool is_ctx, int rowb  , int axis, int j0,
                                                             bf16_t* dst, int ld, int c1, int dx2, float sc, int cz  ) const {
#pragma unroll
        for (int ai = 0; ai < 2; ++ai)
#pragma unroll
            for (int m = 0; m < 4; ++m) { const int row = row0 + ai * 128 + m * 16; float y1[8], y2[8];
                if (!is_ctx) { const int t = row - rowb, pos = axis ? (t & 63) : (t >> 6); const f32x4* tp = (const f32x4*)(rope + (size_t)(pos * NQ + j0) * 2);
#pragma unroll
                    for (int q = 0; q < 4; ++q) { const f32x4 cs = tp[q];
#pragma unroll
                        for (int hh = 0; hh < 2; ++hh) { const int e = 2 * q + hh; const float c = hh ? cs[2] : cs[0], s = hh ? cs[3] : cs[1];
                            const float x1 = acc[ai][0][m][e >> 2][e & 3], x2 = acc[ai][1][m][e >> 2][e & 3];
                            y1[e] = (x1 * c - x2 * s) * sc; y2[e] = (x2 * c + x1 * s) * sc; } }
                } else {
#pragma unroll
                    for (int e = 0; e < 8; ++e) { y1[e] = acc[ai][0][m][e >> 2][e & 3] * sc; y2[e] = acc[ai][1][m][e >> 2][e & 3] * sc; }
                }
                bf16_t* rp = dst + (size_t)row * ld;
                *(u32x4*)(rp + c1) = pack8(y1); *(u32x4*)(rp + c1 + dx2) = pack8(y2);
                if (cz >= 0) { const u32x4 z = {0u, 0u, 0u, 0u}; *(u32x4*)(rp + cz) = z; *(u32x4*)(rp + cz + dx2) = z; }
                asm volatile("" ::: "memory"); }
    }
    __device__ __forceinline__ void operator()(const f32x4 (&acc)[2][2][4][2], const Unit& u, int wr, int wc, int fr, int fq) const {
        asm volatile("" : "+v"(fr), "+v"(fq));
        const int row0 = u.pm * BM + wr * 64 + fr;
        const int batch = u.pm / 17; const bool is_ctx = (u.pm % 17) == 0; const int rowb = batch * TB + CTXL;
        unsigned char* const BIG = ws + WS_BIG;
        if (kind == K_SWIGLU) {
            bf16_t* o0 = (bf16_t*)BIG;
#pragma unroll
            for (int ai = 0; ai < 2; ++ai)
#pragma unroll
                for (int m = 0; m < 4; ++m) { float v[8];
#pragma unroll
                    for (int e = 0; e < 8; ++e) v[e] = siluf(acc[ai][0][m][e >> 2][e & 3]) * acc[ai][1][m][e >> 2][e & 3];
                    *(u32x4*)(o0 + (size_t)(row0 + ai * 128 + m * 16) * FF + u.pn * 128 + wc * 32 + 8 * fq) = pack8(v);
                    asm volatile("" ::: "memory"); }
        } else if (kind == K_RESID) {
            const int mrow = is_ctx ? 4 : batch; const int col0 = u.pn * BM + wc * 32 + 8 * fq; const int gidx = aux & 15, ll = aux >> 4;
            const float gs = gidx == 5 ? 1.f : 0.5f; float* f0 = (float*)(ws + WS_H);
            const float* g = (const float*)(ws + WS_MOD) + (size_t)(ll * 5 + mrow) * NMOD + gidx * DM + col0;
            f32x4 gv[2][2];
#pragma unroll
            for (int bj = 0; bj < 2; ++bj)
#pragma unroll
                for (int n = 0; n < 2; ++n) gv[bj][n] = *(const f32x4*)(g + bj * 128 + 4 * n) * gs;
#pragma unroll
            for (int ai = 0; ai < 2; ++ai)
#pragma unroll
                for (int m = 0; m < 4; ++m) { float* hp = f0 + (size_t)(row0 + ai * 128 + m * 16) * DM + col0;
#pragma unroll
                    for (int bj = 0; bj < 2; ++bj)
#pragma unroll
                        for (int n = 0; n < 2; ++n) { f32x4 h = *(f32x4*)(hp + bj * 128 + 4 * n); h += gv[bj][n] * acc[ai][bj][m][n]; *(f32x4*)(hp + bj * 128 + 4 * n) = h; }
                    asm volatile("" ::: "memory"); }
        } else if (kind == K_PART) {
            const int col0 = u.pn * BM + wc * 32 + 8 * fq; const int gidx = aux & 15, ll = aux >> 4; const float gs = gidx == 5 ? 1.f : 0.5f;
            const float* g = (const float*)(ws + WS_MOD) + (size_t)(ll * 5 + 4) * NMOD + gidx * DM + col0;
            float* part = (float*)(BIG + 3 * U1) + ((size_t)(u.kb >> 9) * 1024 + batch * 256 + (row0 - batch * TB)) * DM + col0;
            f32x4 gv[2][2];
#pragma unroll
            for (int bj = 0; bj < 2; ++bj)
#pragma unroll
                for (int n = 0; n < 2; ++n) gv[bj][n] = *(const f32x4*)(g + bj * 128 + 4 * n) * gs;
#pragma unroll
            for (int ai = 0; ai < 2; ++ai)
#pragma unroll
                for (int m = 0; m < 4; ++m) { float* pp = part + (size_t)(ai * 128 + m * 16) * DM;
#pragma unroll
                    for (int bj = 0; bj < 2; ++bj)
#pragma unroll
                        for (int n = 0; n < 2; ++n) *(f32x4*)(pp + bj * 128 + 4 * n) = gv[bj][n] * acc[ai][bj][m][n];
                    asm volatile("" ::: "memory"); }
        } else if (kind == K_DIFF) {
            const float* rope = (const float*)(ws + WS_ROPE) + ROPE16;
            if (u.pn < 8) { const int axis = fq >> 1, j0 = (fq & 1) * 8;
                if (u.pn < 4) { const int ug = u.pn * 4 + wc; roped<16>(rope, acc, row0, is_ctx, rowb, axis, j0, (bf16_t*)BIG, 2048, ug * 128 + (ug & 1) * 64 + axis * 32 + j0, 16, 0.125f, ug * 128 + ((ug & 1) ^ 1) * 64 + axis * 32 + j0); }
                else roped<16>(rope, acc, row0, is_ctx, rowb, axis, j0, (bf16_t*)(BIG + 2 * U1), 1024, (u.pn - 4) * 256 + wc * 64 + axis * 32 + j0, 16, 1.f, -1);
            } else plain(acc, row0, wc, fq, (bf16_t*)(BIG + 3 * U1), 1024, (u.pn - 8) * 256, 0);
        } else if (kind == K_RET) {
            const float* rope = (const float*)(ws + WS_ROPE) + ROPE64;
            if (u.pn < 8) { const int axis = wc >> 1, j0 = (wc & 1) * 32 + 8 * fq;
                if (u.pn < 4) roped<64>(rope, acc, row0, is_ctx, rowb, axis, j0, (bf16_t*)BIG, 1024, u.pn * 256 + axis * 128 + j0, 64, 1.f, -1);
                else roped<64>(rope, acc, row0, is_ctx, rowb, axis, j0, (bf16_t*)(BIG + U1), 1024, (u.pn - 4) * 256 + axis * 128 + j0, 64, 0.0625f, -1);
            } else if (u.pn < 16) plain(acc, row0, wc, fq, (bf16_t*)(BIG + 2 * U1), 2048, (u.pn - 8) * 256, 0);
            else plain(acc, row0, wc, fq, (bf16_t*)(BIG + 4 * U1), 2048, (u.pn - 16) * 256, 1);
        } else if (kind == K_HGRN) {
            if (u.pn < 4) plain(acc, row0, wc, fq, (bf16_t*)BIG, 1024, u.pn * 256, 1);
            else if (u.pn < 8) plain(acc, row0, wc, fq, (bf16_t*)(BIG + U1), 1024, (u.pn - 4) * 256, 0);
            else if (u.pn < 12) plain(acc, row0, wc, fq, (bf16_t*)(BIG + 2 * U1), 1024, (u.pn - 8) * 256, 1);
            else { const int cb = (u.pn - 12) * 256 + wc * 32 + 8 * fq; float* f0 = (float*)(BIG + 3 * U1); const float* lbv = (const float*)(ws + WS_LBV);
#pragma unroll
                for (int bj = 0; bj < 2; ++bj) { const int c = cb + bj * 128; f32x4 lb0 = *(const f32x4*)(lbv + (c & 1023)), lb1 = *(const f32x4*)(lbv + (c & 1023) + 4);
#pragma unroll
                    for (int ai = 0; ai < 2; ++ai)
#pragma unroll
                        for (int m = 0; m < 4; ++m) { float* rp = f0 + (size_t)(row0 + ai * 128 + m * 16) * 2048 + c; f32x4 r0, r1;
#pragma unroll
                            for (int i = 0; i < 4; ++i) { const float z0 = acc[ai][bj][m][0][i], z1 = acc[ai][bj][m][1][i];
                                const float s0 = __builtin_amdgcn_rcpf(1.f + __expf(-z0)), s1 = __builtin_amdgcn_rcpf(1.f + __expf(-z1));
                                r0[i] = __logf(lb0[i] + (1.f - lb0[i]) * s0); r1[i] = __logf(lb1[i] + (1.f - lb1[i]) * s1); }
                            *(f32x4*)rp = r0; *(f32x4*)(rp + 4) = r1; asm volatile("" ::: "memory"); } } }
        } else {
            if (u.pn < 5) { const int cb = u.pn * 256 + wc * 32 + 8 * fq; float* f0 = (float*)BIG;
#pragma unroll
                for (int ai = 0; ai < 2; ++ai)
#pragma unroll
                    for (int m = 0; m < 4; ++m) { float* rp = f0 + (size_t)(row0 + ai * 128 + m * 16) * 1280 + cb;
#pragma unroll
                        for (int bj = 0; bj < 2; ++bj) { *(f32x4*)(rp + bj * 128) = acc[ai][bj][m][0]; *(f32x4*)(rp + bj * 128 + 4) = acc[ai][bj][m][1]; } }
            } else plain(acc, row0, wc, fq, (bf16_t*)(BIG + 6 * U1), 1024, 0, 0);
        }
    }
};

template <class Epi, class Sched>
__device__ __forceinline__ void gemm_phase(LAS unsigned char* lds, const Gemm g, const Sched& S, const Epi& E, const int tid) {
    const int wid = __builtin_amdgcn_readfirstlane(tid >> 6), lane = tid & 63, wr = wid >> 2, wc = wid & 3, fr = lane & 15, fq = lane >> 4;
    const int K = g.K, nt = g.nt;
    unsigned voffA[2], voffB[2];
#pragma unroll
    for (int i = 0; i < 2; ++i) { int R, C; stage_rc(tid * 16 + i * 8192, R, C); const int Rb = Epi::PERM ? ((R & ~31) + perm32(R & 31)) : R;
        voffA[i] = (unsigned)(R * K + C) * 2u; voffB[i] = (unsigned)(Rb * K + C) * 2u; }
    const size_t kstep = (size_t)(BK * 2);
    const size_t hstep = (size_t)HALF * K * 2;
    const size_t tstep = 2 * hstep;
    const unsigned ldsw = (unsigned)wid * 1024u;
    const int aoff = lds_byte(wr * 64 + fr, fq * 8), boff = lds_byte(wc * 32 + fr, fq * 8);
#define PG8_SA(b, h) (((b) * 2 + (h)) * HTB)
#define PG8_SB(b, h) ((4 + (b) * 2 + (h)) * HTB)
#define PG8_STAGE(bufoff, gbase, voff) do { _Pragma("unroll") for (int _i = 0; _i < 2; ++_i) \
        __builtin_amdgcn_global_load_lds((const unsigned*)((const char*)(gbase) + (voff)[_i]), (LAS unsigned*)(lds + (bufoff) + ldsw + _i * 8192), 16, 0, 0); } while (0)
#define PG8_LDA(dst, b, h) do { _Pragma("unroll") for (int m = 0; m < 4; ++m) _Pragma("unroll") for (int k = 0; k < 2; ++k) dst[m][k] = *(const LAS bf16x8*)(lds + PG8_SA(b, h) + aoff + m * 2048 + k * 1024); } while (0)
#define PG8_LDB(dst, b, h) do { _Pragma("unroll") for (int n = 0; n < 2; ++n) _Pragma("unroll") for (int k = 0; k < 2; ++k) dst[n][k] = *(const LAS bf16x8*)(lds + PG8_SB(b, h) + boff + n * 2048 + k * 1024); } while (0)
#define PG8_MMA(ai, bj, At, Bt) do { __builtin_amdgcn_s_setprio(1); _Pragma("unroll") for (int m = 0; m < 4; ++m) _Pragma("unroll") for (int n = 0; n < 2; ++n) _Pragma("unroll") for (int k = 0; k < 2; ++k) \
        acc[ai][bj][m][n] = __builtin_amdgcn_mfma_f32_16x16x32_bf16(Bt[n][k], At[m][k], acc[ai][bj][m][n], 0, 0, 0); __builtin_amdgcn_s_setprio(0); } while (0)
#define PG8_WAIT_V(n) asm volatile("s_waitcnt vmcnt(" #n ")" ::: "memory")
#define PG8_WAIT_L(n) asm volatile("s_waitcnt lgkmcnt(" #n ")" ::: "memory")
#define PG8_BAR __builtin_amdgcn_s_barrier()
#define PG8_SCHED __builtin_amdgcn_sched_barrier(0)
    Unit cur, nxt; int ui = 0;
    if (!S.next(0, cur)) return;
    f32x4 acc[2][2][4][2];
#pragma unroll
    for (int a = 0; a < 2; ++a)
#pragma unroll
        for (int b = 0; b < 2; ++b)
#pragma unroll
            for (int m = 0; m < 4; ++m)
#pragma unroll
                for (int n = 0; n < 2; ++n) acc[a][b][m][n] = (f32x4){0.f, 0.f, 0.f, 0.f};
    bf16x8 At[4][2], B0[2][2], B1[2][2];
    const char* cA = (const char*)g.A + (size_t)cur.pm * tstep + cur.kb; const char* cB = (const char*)g.Bt + (size_t)cur.pn * tstep + cur.kb;
    PG8_STAGE(PG8_SB(0, 0), cB, voffB); PG8_STAGE(PG8_SB(0, 1), cB + hstep, voffB); PG8_STAGE(PG8_SA(0, 0), cA, voffA); PG8_STAGE(PG8_SA(0, 1), cA + hstep, voffA);
    if (wr == 1) PG8_BAR;
    PG8_WAIT_V(2); PG8_BAR;
    PG8_STAGE(PG8_SB(1, 0), cB + kstep, voffB); PG8_STAGE(PG8_SA(1, 0), cA + kstep, voffA); PG8_STAGE(PG8_SB(1, 1), cB + hstep + kstep, voffB);
    PG8_WAIT_V(6); PG8_BAR;
    for (;;) {
        const bool has_next = S.next(ui + 1, nxt);
        const char* nA = has_next ? (const char*)g.A + (size_t)nxt.pm * tstep + nxt.kb : cA; const char* nB = has_next ? (const char*)g.Bt + (size_t)nxt.pn * tstep + nxt.kb : cB;
        for (int t = 0; t < nt; t += 2) {
            const bool last = (t == nt - 2);
            const char* a1 = cA + (size_t)(t + 1) * kstep;
            const char* a2 = last ? nA : cA + (size_t)(t + 2) * kstep; const char* b2 = last ? nB : cB + (size_t)(t + 2) * kstep;
            const char* a3 = a2 + kstep; const char* b3 = b2 + kstep;
            PG8_LDB(B0, 0, 0); PG8_LDB(B1, 0, 1); PG8_SCHED; PG8_LDA(At, 0, 0); PG8_STAGE(PG8_SA(1, 1), a1 + hstep, voffA);
            PG8_WAIT_V(8); PG8_WAIT_L(0); PG8_BAR; PG8_MMA(0, 0, At, B0); PG8_MMA(0, 1, At, B1); PG8_BAR; PG8_SCHED;
            PG8_LDA(At, 0, 1); PG8_STAGE(PG8_SB(0, 0), b2, voffB); PG8_STAGE(PG8_SB(0, 1), b2 + hstep, voffB); PG8_STAGE(PG8_SA(0, 0), a2, voffA);
            PG8_WAIT_V(8); PG8_WAIT_L(0); PG8_BAR; PG8_MMA(1, 0, At, B0); PG8_MMA(1, 1, At, B1); PG8_BAR; PG8_SCHED;
            PG8_LDB(B0, 1, 0); PG8_LDB(B1, 1, 1); PG8_SCHED; PG8_LDA(At, 1, 0); PG8_STAGE(PG8_SA(0, 1), a2 + hstep, voffA);
            PG8_WAIT_V(8); PG8_WAIT_L(0); PG8_BAR; PG8_MMA(0, 0, At, B0); PG8_MMA(0, 1, At, B1); PG8_BAR; PG8_SCHED;
            PG8_LDA(At, 1, 1); PG8_STAGE(PG8_SB(1, 0), b3, voffB); PG8_STAGE(PG8_SB(1, 1), b3 + hstep, voffB); PG8_STAGE(PG8_SA(1, 0), a3, voffA);
            PG8_WAIT_V(8); PG8_WAIT_L(0); PG8_BAR; PG8_MMA(1, 0, At, B0); PG8_MMA(1, 1, At, B1); PG8_BAR; PG8_SCHED;
        }
        if (wr == 0) PG8_BAR;
        E(acc, cur, wr, wc, fr, fq);
        if (!has_next) break;
#pragma unroll
        for (int a = 0; a < 2; ++a)
#pragma unroll
            for (int b = 0; b < 2; ++b)
#pragma unroll
                for (int m = 0; m < 4; ++m)
#pragma unroll
                    for (int n = 0; n < 2; ++n) acc[a][b][m][n] = (f32x4){0.f, 0.f, 0.f, 0.f};
        cur = nxt; cA = nA; cB = nB; ++ui;
        if (wr == 1) PG8_BAR;
    }
    PG8_WAIT_V(0);
    PG8_BAR;
#undef PG8_SA
#undef PG8_SB
#undef PG8_STAGE
#undef PG8_LDA
#undef PG8_LDB
#undef PG8_MMA
#undef PG8_WAIT_V
#undef PG8_WAIT_L
#undef PG8_BAR
#undef PG8_SCHED
}
}

namespace att {
constexpr int D = 128, NW = 8, QBLK = 32, KVBLK = 64;
constexpr float THR = 8.f;
#ifndef ATT_SDEPTH
#define ATT_SDEPTH 1
#endif
constexpr size_t SHM_V = KVBLK * D * 2, SHM_K = KVBLK * D * 2, SHM_ATTN = 2 * SHM_V + 2 * SHM_K + NW * 64 * 4;
#define KSWZ(row, colB) ((row) * 256 + ((colB) ^ (((row) & 7) << 4)))
#define SBAR() __builtin_amdgcn_sched_barrier(0)
__device__ __forceinline__ int crow(int r, int hi) { return (r & 3) + 8 * (r >> 2) + 4 * hi; }
__device__ __forceinline__ void partialSM(f32x16& p0, f32x16& p1, float& m_reg, float& mn, float& alpha, float C, float thr) {
  float pmax = p0[0]; for (int r = 1; r < 16; ++r) pmax = fmaxf(pmax, p0[r]); for (int r = 0; r < 16; ++r) pmax = fmaxf(pmax, p1[r]);
  { auto rr = __builtin_amdgcn_permlane32_swap(__float_as_uint(pmax), __float_as_uint(pmax), false, false);
    pmax = fmaxf(__uint_as_float(rr[0]), __uint_as_float(rr[1])); }
  if (__builtin_expect(__all(pmax - m_reg <= thr), 1)) { mn = m_reg; alpha = 1.f; }
  else { mn = fmaxf(m_reg, pmax); alpha = __builtin_amdgcn_exp2f((m_reg - mn) * C); m_reg = mn; }
  float mnC = -mn * C;
  for (int r = 0; r < 16; ++r) p0[r] = fmaf(p0[r], C, mnC); for (int r = 0; r < 16; ++r) p1[r] = fmaf(p1[r], C, mnC);
  for (int r = 0; r < 16; ++r) p0[r] = __builtin_amdgcn_exp2f(p0[r]);
}
__device__ __forceinline__ void finishSM(f32x16& p0, f32x16& p1, float alpha, float& l_reg, bf16x8& pa0, bf16x8& pa1, bf16x8& pa2, bf16x8& pa3) {
  for (int r = 0; r < 16; ++r) p1[r] = __builtin_amdgcn_exp2f(p1[r]);
  float ps = 0; for (int r = 0; r < 16; ++r) ps += p0[r]; for (int r = 0; r < 16; ++r) ps += p1[r];
  { auto rr = __builtin_amdgcn_permlane32_swap(__float_as_uint(ps), __float_as_uint(ps), false, false);
    ps = __uint_as_float(rr[0]) + __uint_as_float(rr[1]); }
  l_reg = l_reg * alpha + ps;
#define PK4(P, BASE, OUT) do { unsigned a0 = cvt_pk_bf16(P[BASE + 0], P[BASE + 1]), a1 = cvt_pk_bf16(P[BASE + 2], P[BASE + 3]);   \
    unsigned b0 = cvt_pk_bf16(P[BASE + 4], P[BASE + 5]), b1 = cvt_pk_bf16(P[BASE + 6], P[BASE + 7]);                              \
    auto r0 = __builtin_amdgcn_permlane32_swap(a0, b0, false, false); auto r1 = __builtin_amdgcn_permlane32_swap(a1, b1, false, false); \
    u32x4 w = {r0[0], r1[0], r0[1], r1[1]}; OUT = *reinterpret_cast<bf16x8*>(&w); } while (0)
  PK4(p0, 0, pa0); PK4(p0, 8, pa1); PK4(p1, 0, pa2); PK4(p1, 8, pa3);
#undef PK4
}
#define QKT_STEP(d0) do { const int cb = ((d0) * 16 + hi * 8) * 2; \
    const bf16x8 b0 = *reinterpret_cast<const bf16x8*>((const char*)Ks + KSWZ(r32, cb)); \
    const bf16x8 b1 = *reinterpret_cast<const bf16x8*>((const char*)Ks + KSWZ(32 + r32, cb)); \
    p0 = __builtin_amdgcn_mfma_f32_32x32x16_bf16(b0, qr[d0], p0, 0, 0, 0); \
    p1 = __builtin_amdgcn_mfma_f32_32x32x16_bf16(b1, qr[d0], p1, 0, 0, 0); } while (0)
template <int qh> __device__ __forceinline__ void qkt(f32x16& p0, f32x16& p1, const bf16_t* Ks, const bf16x8* qr, int r32, int hi) {
  p0 = f32x16{}; p1 = f32x16{};
  if constexpr (qh != 2) { QKT_STEP(0); QKT_STEP(1); QKT_STEP(2); QKT_STEP(3); }
  if constexpr (qh != 1) { QKT_STEP(4); QKT_STEP(5); QKT_STEP(6); QKT_STEP(7); }
}
__device__ __forceinline__ int v_st(int k, int c) { const int kk = (k & ~0xC) | ((k & 4) << 1) | ((k & 8) >> 1); return ((kk >> 3) * 4 + (c >> 5)) * 512 + ((kk & 7) * 32 + (c & 31)) * 2; }
__device__ __forceinline__ int v_rd_base(int lane) { return ((lane & 3) << 3) | (((lane >> 2) & 3) << 6) | (((lane >> 4) & 1) << 5) | (((lane >> 5) & 1) << 8); }
constexpr int v_rd_off(int d0, int ks, int half) { return d0 * 512 + ks * 4096 + half * 2048; }
template <int OFF> __device__ __forceinline__ s16x4 tr_read(int vb) {
  s16x4 r; asm volatile("ds_read_b64_tr_b16 %0, %1 offset:%2" : "=&v"(r) : "v"(vb), "i"(OFF) : "memory"); return r;
}
template <int D0> __device__ __forceinline__ void pv_one(f32x16& od, int vb, bf16x8 pa0, bf16x8 pa1, bf16x8 pa2, bf16x8 pa3) {
  const s16x4 l0 = tr_read<v_rd_off(D0, 0, 0)>(vb), h0 = tr_read<v_rd_off(D0, 0, 1)>(vb), l1 = tr_read<v_rd_off(D0, 1, 0)>(vb), h1 = tr_read<v_rd_off(D0, 1, 1)>(vb);
  const s16x4 l2 = tr_read<v_rd_off(D0, 2, 0)>(vb), h2 = tr_read<v_rd_off(D0, 2, 1)>(vb), l3 = tr_read<v_rd_off(D0, 3, 0)>(vb), h3 = tr_read<v_rd_off(D0, 3, 1)>(vb);
  asm volatile("s_waitcnt lgkmcnt(0)" ::: "memory"); SBAR();
#define PK(L, H) (bf16x8){L[0], L[1], L[2], L[3], H[0], H[1], H[2], H[3]}
  od = __builtin_amdgcn_mfma_f32_32x32x16_bf16(pa0, PK(l0, h0), od, 0, 0, 0);
  od = __builtin_amdgcn_mfma_f32_32x32x16_bf16(pa1, PK(l1, h1), od, 0, 0, 0);
  od = __builtin_amdgcn_mfma_f32_32x32x16_bf16(pa2, PK(l2, h2), od, 0, 0, 0);
  od = __builtin_amdgcn_mfma_f32_32x32x16_bf16(pa3, PK(l3, h3), od, 0, 0, 0);
#undef PK
}
__device__ __forceinline__ void pv_d0(f32x16* o, int vb, bf16x8 pa0, bf16x8 pa1, bf16x8 pa2, bf16x8 pa3) {
  pv_one<0>(o[0], vb, pa0, pa1, pa2, pa3); pv_one<1>(o[1], vb, pa0, pa1, pa2, pa3); pv_one<2>(o[2], vb, pa0, pa1, pa2, pa3); pv_one<3>(o[3], vb, pa0, pa1, pa2, pa3);
}
template <int QH> __device__ __forceinline__ void attn_dense_body(const bf16_t* __restrict__ Qb, const bf16_t* __restrict__ Kh, const bf16_t* __restrict__ Vh,
                                                bf16_t* __restrict__ Ob, int seq, float scale, char* lds, const int tid) {
  constexpr int LDQ = 2048, LDK = 1024, LDO = 1024, SLOT = 32768;
  const float C = scale * 1.4426950408889634f, thr = THR / scale;
  const int wid = __builtin_amdgcn_readfirstlane(tid >> 6), lane = tid & 63, r32 = lane & 31, hi = lane >> 5;
  LAS unsigned char* L3 = (LAS unsigned char*)lds;
  float* ws = (float*)(lds + 4 * SLOT) + wid * 64; float* li_l = ws; float* al_l = ws + 32;
  float m_reg = -1e30f, l_reg = 0; f32x16 o[4] = {}; bf16x8 qr[8];
  const bf16_t* Qw = Qb + (long)(wid * QBLK + r32) * LDQ + hi * 8;
#pragma unroll
  for (int d0 = 0; d0 < 8; ++d0) qr[d0] = *reinterpret_cast<const bf16x8*>(Qw + d0 * 16);
  unsigned ko[2], vo[2];
#pragma unroll
  for (int n = 0; n < 2; ++n) { const int d = (n * 8 + wid) * 1024 + lane * 16;
    { const int r = d >> 8, pos = (d & 255) >> 4, c = pos ^ (r & 7); ko[n] = (unsigned)(r * LDK + c * 8) * 2u; }
    { const int sb = d >> 9, e = d & 511, kk = (sb >> 2) * 8 + (e >> 6), k = (kk & ~0xC) | ((kk & 4) << 1) | ((kk & 8) >> 1), c = (sb & 3) * 32 + ((e & 63) >> 1); vo[n] = (unsigned)(k * LDK + c) * 2u; } }
  const int vrb = (int)(uintptr_t)lds + 16384 + v_rd_base(lane);
#define ADMA(t) do { const size_t tb_ = (size_t)(t) * (size_t)(KVBLK * LDK * 2); const unsigned so_ = (unsigned)((t) & 3) * SLOT + (unsigned)wid * 1024u; \
    _Pragma("unroll") for (int n_ = 0; n_ < 2; ++n_) { \
      __builtin_amdgcn_global_load_lds((const unsigned*)((const char*)Kh + tb_ + ko[n_]), (LAS unsigned*)(L3 + so_ + n_ * 8192), 16, 0, 0); \
      __builtin_amdgcn_global_load_lds((const unsigned*)((const char*)Vh + tb_ + vo[n_]), (LAS unsigned*)(L3 + so_ + 16384 + n_ * 8192), 16, 0, 0); } } while (0)
#define AWAIT(more) do { if (more) asm volatile("s_waitcnt vmcnt(4)" ::: "memory"); else asm volatile("s_waitcnt vmcnt(0)" ::: "memory"); } while (0)
#define ABAR() do { asm volatile("s_waitcnt lgkmcnt(0)" ::: "memory"); __builtin_amdgcn_s_barrier(); asm volatile("" ::: "memory"); } while (0)
#define KSLOT(t) ((const bf16_t*)(lds + ((t) & 3) * SLOT))
#define VSLOT(t) (vrb + ((t) & 3) * SLOT)
#define RESC(a) do { if (__any((a) < 1.f)) { if (hi == 0) al_l[r32] = (a); asm volatile("s_waitcnt lgkmcnt(0)" ::: "memory"); \
    for (int d = 0; d < 4; ++d) for (int r = 0; r < 16; ++r) o[d][r] *= al_l[crow(r, hi)]; } } while (0)
  f32x16 pA0, pA1, pB0, pB1; float mnA, mnB, alA, alB; bf16x8 pa0, pa1, pa2, pa3; const int NT = seq / KVBLK;
  ADMA(0); ADMA(1);
  asm volatile("s_waitcnt vmcnt(4)" ::: "memory"); ABAR();
  if (2 < NT) ADMA(2);
  qkt<QH>(pA0, pA1, KSLOT(0), qr, r32, hi); partialSM(pA0, pA1, m_reg, mnA, alA, C, thr);
  AWAIT(2 < NT); ABAR();
  for (int j = 1; j + 1 < NT; j += 2) {
    if (j + 2 < NT) ADMA(j + 2);
    SBAR(); qkt<QH>(pB0, pB1, KSLOT(j), qr, r32, hi);
    finishSM(pA0, pA1, alA, l_reg, pa0, pa1, pa2, pa3); SBAR();
    pv_d0(o, VSLOT(j - 1), pa0, pa1, pa2, pa3); partialSM(pB0, pB1, m_reg, mnB, alB, C, thr);
    AWAIT(j + 2 < NT); ABAR();
    RESC(alB);
    if (j + 3 < NT) ADMA(j + 3);
    SBAR(); qkt<QH>(pA0, pA1, KSLOT(j + 1), qr, r32, hi);
    finishSM(pB0, pB1, alB, l_reg, pa0, pa1, pa2, pa3); SBAR();
    pv_d0(o, VSLOT(j), pa0, pa1, pa2, pa3); partialSM(pA0, pA1, m_reg, mnA, alA, C, thr);
    AWAIT(j + 3 < NT); ABAR();
    RESC(alA);
  }
  SBAR(); qkt<QH>(pB0, pB1, KSLOT(NT - 1), qr, r32, hi);
  finishSM(pA0, pA1, alA, l_reg, pa0, pa1, pa2, pa3); SBAR();
  pv_d0(o, VSLOT(NT - 2), pa0, pa1, pa2, pa3); partialSM(pB0, pB1, m_reg, mnB, alB, C, thr);
  RESC(alB);
  finishSM(pB0, pB1, alB, l_reg, pa0, pa1, pa2, pa3); SBAR();
  pv_d0(o, VSLOT(NT - 1), pa0, pa1, pa2, pa3);
  if (hi == 0) li_l[r32] = l_reg; asm volatile("s_waitcnt lgkmcnt(0)" ::: "memory");
  float rli[16];
#pragma unroll
  for (int r = 0; r < 16; ++r) rli[r] = __builtin_amdgcn_rcpf(li_l[crow(r, hi)]);
  bf16_t* Ow = Ob + (long)(wid * QBLK) * LDO;
#pragma unroll
  for (int r = 0; r < 16; ++r) { int orow = crow(r, hi);
    for (int d0 = 0; d0 < 4; ++d0) Ow[(long)orow * LDO + d0 * 32 + r32] = f2bf(o[d0][r] * rli[r]); }
#undef ADMA
#undef AWAIT
#undef ABAR
#undef KSLOT
#undef VSLOT
#undef RESC
}
}

template <int DK, int DVS, bool RET>
__device__ __forceinline__ void gla_unit(unsigned char* lds, int b, int h, int dir, int slice,
                                         const bf16_t* __restrict__ Q, const bf16_t* __restrict__ Kp, const bf16_t* __restrict__ V, const float* __restrict__ LF,
                                         bf16_t* __restrict__ Od, float lg, int ldv, int vcol0, const int tid) {
    constexpr int LK = DK + 8, LS = 72, NPG = 512 / DK, PPT = 64 / NPG, VPT = DVS / 8;
    constexpr int NVT = DVS / 16, NKT = DK / 16, TPW = NVT * NKT / 8, WPV = 8 / NVT, NOT = DVS / 32;
    constexpr int LV = DVS + 8;
    unsigned aQD = (unsigned)(uintptr_t)(LAS unsigned char*)lds, aKD = aQD + 64 * LK * 2, aSTB = aKD + 64 * LK * 2, aVI = aSTB + DVS * LK * 2,
             aAT = aVI + 64 * LV * 2, aEL = aAT + 64 * LS * 2, aTOT = aEL + DK * 4;
    asm volatile("" : "+s"(aQD), "+s"(aVI), "+s"(aAT), "+s"(aEL), "+s"(aTOT), "+s"(aKD), "+s"(aSTB));
    LAS bf16_t* QD = (LAS bf16_t*)(uintptr_t)aQD; LAS bf16_t* VI = (LAS bf16_t*)(uintptr_t)aVI; LAS bf16_t* AT = (LAS bf16_t*)(uintptr_t)aAT;
    LAS float* EL = (LAS float*)(uintptr_t)aEL; LAS float* TOT = (LAS float*)(uintptr_t)aTOT;
    LAS bf16_t* KD = (LAS bf16_t*)(uintptr_t)aKD; LAS bf16_t* STB = (LAS bf16_t*)(uintptr_t)aSTB;
    static_assert(2 * 64 * LK * 2 + DVS * LK * 2 + 64 * LV * 2 + 64 * LS * 2 + DK * 4 + 2048 <= 159744, "GLA LDS map");
    const int wid = tid >> 6, lane = tid & 63, l16 = lane & 15, quad = lane >> 4;
    const int tr = wid >> 1, tv = wid / WPV, kt0 = (wid % WPV) * TPW;
    const int vtr = (int)aVI + (8 * quad + (l16 >> 2)) * (LV * 2) + 8 * (lane & 3);
    const int ktr = (int)aKD + (8 * quad + (l16 >> 2)) * (LK * 2) + 8 * (lane & 3);
#define TRR(dst, base, OFF) asm volatile("ds_read_b64_tr_b16 %0, %1 offset:%2" : "=&v"(dst) : "v"(base), "i"(OFF) : "memory")
#define TRFRAG(L, H) (bf16x8){L[0], L[1], L[2], L[3], H[0], H[1], H[2], H[3]}
    f32x4 st[TPW];
#pragma unroll
    for (int t = 0; t < TPW; ++t) st[t] = (f32x4){0.f, 0.f, 0.f, 0.f};
#define GLA_BAR() do { asm volatile("s_waitcnt lgkmcnt(0)" ::: "memory"); __builtin_amdgcn_s_barrier(); asm volatile("" ::: "memory"); } while (0)
    typedef short vvec_t __attribute__((ext_vector_type(VPT)));
    constexpr int NQV = RET ? 4 : 1, NLC = RET ? 1 : PPT;
    bf16x8 qv[NQV], kv[NQV]; float lc[NLC]; bf16_t qr[NLC]; vvec_t vraw;
    const int kx = tid % DK, pg = tid / DK;
    const GAS bf16_t* Qg = (const GAS bf16_t*)Q; const GAS bf16_t* Kg = (const GAS bf16_t*)Kp; const GAS float* LFg = (const GAS float*)LF; const GAS bf16_t* Vg = (const GAS bf16_t*)V;
#define GLA_LOAD(SX) do { const int sx_ = (SX); const int cx_ = dir ? (sx_ < 4 ? 3 - sx_ : 71 - sx_) : sx_; const long Rx_ = (long)b * TB + cx_ * 64; \
        if constexpr (RET) { _Pragma("unroll") for (int j = 0; j < 4; ++j) { const int it = tid + 512 * j, p = it & 63, k0 = (it >> 6) * 8; const long row = Rx_ + (dir ? 63 - p : p); \
                qv[j] = *(const GAS bf16x8*)(Qg + row * 1024 + h * DK + k0); kv[j] = *(const GAS bf16x8*)(Kg + row * 1024 + h * DK + k0); } } \
        else { _Pragma("unroll") for (int i = 0; i < PPT; ++i) { const int p = pg * PPT + i; const long row = Rx_ + (dir ? 63 - p : p); \
                lc[i] = LFg[row * 2048 + dir * 1024 + h * DK + kx]; qr[i] = Qg[row * 1024 + h * DK + kx]; } } \
        } while (0)
    GLA_LOAD(0);
    for (int step = 0; step < 68; ++step) {
        const int cidx = dir ? (step < 4 ? 3 - step : 71 - step) : step;
        const long R0 = (long)b * TB + cidx * 64;
        GLA_BAR();
        {
#pragma unroll
            for (int t = 0; t < TPW; ++t)
#pragma unroll
                for (int j = 0; j < 4; ++j) STB[(tv * 16 + quad * 4 + j) * LK + (kt0 + t) * 16 + l16] = f2bf(st[t][j]);
            { const int p = tid >> 3, vg = tid & 7; const long row = R0 + (dir ? 63 - p : p); vraw = *(const GAS vvec_t*)(Vg + row * ldv + vcol0 + vg * VPT); }
            float bl;
            if constexpr (RET) {
                static_assert(!RET || DK == 256, "retention prep: 64 x 256 = 2048 eight-wide items, four per thread");
                bl = 64.f * lg;
#pragma unroll
                for (int j = 0; j < 4; ++j) { const int it = tid + 512 * j, p = it & 63, k0 = (it >> 6) * 8; const float bb = (float)(p + 1) * lg;
                    const float eq = __expf(bb), ek = __expf(-bb); float a[8], c[8];
#pragma unroll
                    for (int e = 0; e < 8; ++e) { a[e] = bf2f((bf16_t)qv[j][e]) * eq; c[e] = bf2f((bf16_t)kv[j][e]) * ek; }
                    *(LAS u32x4*)(QD + p * LK + k0) = pack8(a); *(LAS u32x4*)(KD + p * LK + k0) = pack8(c); }
            } else {
                float c = 0.f;
#pragma unroll
                for (int i = 0; i < PPT; ++i) c += lc[i];
                TOT[pg * 128 + kx] = c;
                GLA_BAR();
                float off = 0.f; bl = 0.f;
#pragma unroll
                for (int g = 0; g < NPG; ++g) { const float t = TOT[g * 128 + kx]; if (g < pg) off += t; bl += t; }
                float bb = off;
#pragma unroll
                for (int i = 0; i < PPT; ++i) { const int p = pg * PPT + i;
                    const float qf = bf2f(qr[i]), kf = 1.f - __expf(lc[i]); bb += lc[i];
                    QD[p * LK + kx] = f2bf(qf * __expf(bb)); KD[p * LK + kx] = f2bf(kf * __expf(-bb)); }
            }
            if (pg == 0) EL[kx] = __expf(bl);
            { const int p = tid >> 3, vg = tid & 7; *(LAS vvec_t*)(VI + p * LV + vg * VPT) = vraw; }
        }
        if (step + 1 < 68) GLA_LOAD(step + 1);
        GLA_BAR();
        {
            const int tcs = (wid & 1) * 2;
            f32x4 a0 = {0.f, 0.f, 0.f, 0.f}, a1 = {0.f, 0.f, 0.f, 0.f};
#pragma unroll
            for (int kk = 0; kk < DK / 32; ++kk) {
                const bf16x8 af = *(const LAS bf16x8*)(QD + (tr * 16 + l16) * LK + kk * 32 + quad * 8);
                const bf16x8 b0 = *(const LAS bf16x8*)(KD + (tcs * 16 + l16) * LK + kk * 32 + quad * 8);
                const bf16x8 b1 = *(const LAS bf16x8*)(KD + ((tcs + 1) * 16 + l16) * LK + kk * 32 + quad * 8);
                a0 = __builtin_amdgcn_mfma_f32_16x16x32_bf16(af, b0, a0, 0, 0, 0);
                a1 = __builtin_amdgcn_mfma_f32_16x16x32_bf16(af, b1, a1, 0, 0, 0);
                asm volatile("" ::: "memory");
            }
#pragma unroll
            for (int j = 0; j < 4; ++j) { const int p = tr * 16 + quad * 4 + j, s0 = tcs * 16 + l16, s1 = s0 + 16;
                AT[p * LS + s0] = f2bf((s0 <= p) ? a0[j] : 0.f); AT[p * LS + s1] = f2bf((s1 <= p) ? a1[j] : 0.f); }
        }
        GLA_BAR();
#pragma unroll
        for (int t = 0; t < NOT; ++t) { const int tc = (wid & 1) * NOT + t; f32x4 acc = {0.f, 0.f, 0.f, 0.f};
#pragma unroll
            for (int kk = 0; kk < DK / 32; ++kk) {
                const bf16x8 af = *(const LAS bf16x8*)(QD + (tr * 16 + l16) * LK + kk * 32 + quad * 8);
                const bf16x8 bf = *(const LAS bf16x8*)(STB + (tc * 16 + l16) * LK + kk * 32 + quad * 8);
                acc = __builtin_amdgcn_mfma_f32_16x16x32_bf16(af, bf, acc, 0, 0, 0);
                if ((kk & 3) == 3) asm volatile("" ::: "memory"); }
            { s16x4 v00, v01, v10, v11; const int vb = vtr + tc * 32;
                TRR(v00, vb, 0); TRR(v01, vb, 4 * LV * 2); TRR(v10, vb, 32 * LV * 2); TRR(v11, vb, 36 * LV * 2);
                const bf16x8 a0 = *(const LAS bf16x8*)(AT + (tr * 16 + l16) * LS + quad * 8), a1 = *(const LAS bf16x8*)(AT + (tr * 16 + l16) * LS + 32 + quad * 8);
                asm volatile("s_waitcnt lgkmcnt(0)" ::: "memory"); __builtin_amdgcn_sched_barrier(0);
                acc = __builtin_amdgcn_mfma_f32_16x16x32_bf16(a0, TRFRAG(v00, v01), acc, 0, 0, 0);
                acc = __builtin_amdgcn_mfma_f32_16x16x32_bf16(a1, TRFRAG(v10, v11), acc, 0, 0, 0); }
#pragma unroll
            for (int j = 0; j < 4; ++j) { const int p = tr * 16 + quad * 4 + j; const long row = R0 + (dir ? 63 - p : p);
                ((GAS bf16_t*)Od)[row * ldv + vcol0 + tc * 16 + l16] = f2bf(acc[j]); }
        }
        { s16x4 a00, a01, a10, a11; const int vb = vtr + tv * 32;
            TRR(a00, vb, 0); TRR(a01, vb, 4 * LV * 2); TRR(a10, vb, 32 * LV * 2); TRR(a11, vb, 36 * LV * 2);
#pragma unroll
            for (int t0 = 0; t0 < TPW; t0 += 2) {
                s16x4 b[2][4];
#pragma unroll
                for (int u = 0; u < 2; ++u) { const int kb = ktr + (kt0 + t0 + u) * 32;
                    TRR(b[u][0], kb, 0); TRR(b[u][1], kb, 4 * LK * 2); TRR(b[u][2], kb, 32 * LK * 2); TRR(b[u][3], kb, 36 * LK * 2); }
                asm volatile("s_waitcnt lgkmcnt(0)" ::: "memory"); __builtin_amdgcn_sched_barrier(0);
#pragma unroll
                for (int u = 0; u < 2; ++u) { const int t = t0 + u;
                    st[t] = __builtin_amdgcn_mfma_f32_16x16x32_bf16(TRFRAG(a00, a01), TRFRAG(b[u][0], b[u][1]), st[t], 0, 0, 0);
                    st[t] = __builtin_amdgcn_mfma_f32_16x16x32_bf16(TRFRAG(a10, a11), TRFRAG(b[u][2], b[u][3]), st[t], 0, 0, 0); }
            }
#pragma unroll
            for (int t = 0; t < TPW; ++t) st[t] = st[t] * EL[(kt0 + t) * 16 + l16];
        }
    }
    __syncthreads();
#undef TRR
#undef TRFRAG
#undef GLA_BAR
#undef GLA_LOAD
}

constexpr int LDS_BYTES = 160000;
struct Params { const float* in[26]; float* out; unsigned char* ws; };

__device__ __forceinline__ void sincos_cw(float x, float& s, float& c) {
    const float n = rintf(x * 0.6366197723675814f);
    float r = fmaf(-n, 1.5703125f, x); r = fmaf(-n, 4.837512969970703125e-4f, r); r = fmaf(-n, 7.54978995489188216e-8f, r);
    const float z = r * r;
    const float sp = r + r * z * (-1.6666654611e-1f + z * (8.3321608736e-3f + z * (-1.9515295891e-4f)));
    const float cp = 1.f - 0.5f * z + z * z * (4.166664568298827e-2f + z * (-1.388731625493765e-3f + z * 2.443315711809948e-5f));
    const int q = ((int)n) & 3;
    s = (q == 0) ? sp : (q == 1) ? cp : (q == 2) ? -sp : -cp;
    c = (q == 0) ? cp : (q == 1) ? -sp : (q == 2) ? -cp : sp;
}

__device__ __forceinline__ int permrow(int pt, int n) {
    if (pt == 1) { return n < FF ? (n / 128) * 256 + (n % 128) : ((n - FF) / 128) * 256 + 128 + ((n - FF) % 128); }
    if (pt == 2) { if (n >= 2048) return n; const int tile = n >> 8, ut = (n >> 6) & 3, w = n & 63; return tile * 256 + ((w >> 4) & 1) * 128 + ut * 32 + (w >> 5) * 16 + (w & 15); }
    if (pt == 3) { if (n >= 2048) return n; const int tile = n >> 8, w = n & 255; return tile * 256 + ((w >> 6) & 1) * 128 + (w >> 7) * 64 + (w & 63); }
    return n;
}
__device__ __forceinline__ void transpose_item(const float* __restrict__ W, int K, int N, bf16_t* __restrict__ WT, int pt, float* scr, int item, int lane) {
    const int nblk = N / 32, kb = item / nblk, nb = item % nblk, k0 = 64 * kb, n0 = 32 * nb;
#pragma unroll 8
    for (int i = 0; i < 32; ++i) { const int kk = 2 * i + (lane >> 5); scr[kk * 33 + (lane & 31)] = __builtin_nontemporal_load(&W[(size_t)(k0 + kk) * N + n0 + (lane & 31)]); }
    asm volatile("s_waitcnt lgkmcnt(0)" ::: "memory");
    const int c = lane & 7;
#pragma unroll
    for (int j = 0; j < 4; ++j) { const int n = (lane >> 3) + 8 * j; const float* s = scr + (8 * c) * 33 + n;
        u32x4 o; o.x = cvt_pk_bf16(s[0 * 33], s[1 * 33]); o.y = cvt_pk_bf16(s[2 * 33], s[3 * 33]); o.z = cvt_pk_bf16(s[4 * 33], s[5 * 33]); o.w = cvt_pk_bf16(s[6 * 33], s[7 * 33]);
        *(u32x4*)(WT + (size_t)permrow(pt, n0 + n) * K + k0 + 8 * c) = o; }
    asm volatile("s_waitcnt lgkmcnt(0)" ::: "memory");
}

#define XB_XCNT(j)  (64 + 64 * (j))
#define XB_XSUB(j)  (64 * 17 + 64 * (j))
#define XB_XGEN(j)  (64 * 33 + 64 * (j))
#define XB_TOP      (64 * 49)
#define XB_TOPGEN   (64 * 50)
#define XB_WORDS    (64 * 51)
__device__ __forceinline__ unsigned xb_add(unsigned* p, unsigned v) { return __hip_atomic_fetch_add(p, v, __ATOMIC_RELAXED, __HIP_MEMORY_SCOPE_AGENT); }
__device__ __forceinline__ unsigned xb_xcc_id() { return (unsigned)__builtin_amdgcn_s_getreg((3 << 11) | 20) & 0xFu; }
__device__ __forceinline__ void grid_bar(unsigned* bar, volatile LAS unsigned* st, int tid) {
    asm volatile("s_waitcnt vmcnt(0) lgkmcnt(0)" ::: "memory");
    __syncthreads();
    if (tid == 0) {
        const unsigned x = xb_xcc_id();
        unsigned nloc = st[0], nx = st[1];
        if (nloc == 0u) {
            const unsigned Gt = gridDim.x;
            for (;;) { unsigned sum = 0u, cnt = 0u, mine = 0u;
#pragma unroll
                for (unsigned j = 0; j < 16; ++j) { const unsigned c = xb_add(&bar[XB_XCNT(j)], 0u); sum += c; cnt += (c > 0u) ? 1u : 0u; mine = (j == x) ? c : mine; }
                if (sum == Gt) { nloc = mine; nx = cnt; break; }
                __builtin_amdgcn_s_sleep(2); }
            st[0] = nloc; st[1] = nx;
        }
        const unsigned old = xb_add(&bar[XB_XSUB(x)], 1u), gen = old / nloc;
        if (old + 1u == (gen + 1u) * nloc) {
            __builtin_amdgcn_fence(__ATOMIC_RELEASE, "agent");
            asm volatile("s_waitcnt vmcnt(0)" ::: "memory");
            const unsigned og = xb_add(&bar[XB_TOP], 1u), tg = og / nx;
            if (og + 1u == (tg + 1u) * nx) xb_add(&bar[XB_TOPGEN], 1u);
            else while (xb_add(&bar[XB_TOPGEN], 0u) == tg) __builtin_amdgcn_s_sleep(2);
            __builtin_amdgcn_fence(__ATOMIC_ACQUIRE, "agent");
            xb_add(&bar[XB_XGEN(x)], 1u);
            asm volatile("s_waitcnt vmcnt(0)" ::: "memory");
        } else {
            while (xb_add(&bar[XB_XGEN(x)], 0u) == gen) __builtin_amdgcn_s_sleep(2);
            __builtin_amdgcn_fence(__ATOMIC_ACQUIRE, "agent");
            asm volatile("s_waitcnt vmcnt(0)" ::: "memory");
        }
    }
    __syncthreads();
}
__device__ __forceinline__ void norm_row(const f32x4 (&v)[4], const float* __restrict__ sh, const float* __restrict__ sc, bf16_t* __restrict__ orow, int lane) {
    float s = 0.f;
#pragma unroll
    for (int j = 0; j < 4; ++j) s += (v[j].x * v[j].x + v[j].y * v[j].y) + (v[j].z * v[j].z + v[j].w * v[j].w);
    const float rinv = rsqrtf(wave_sum(s) * (1.f / DM) + EPS);
    u32x2* o8 = (u32x2*)orow + lane;
#pragma unroll
    for (int j = 0; j < 4; ++j) { const f32x4 a = *((const f32x4*)sh + lane + 64 * j), b = *((const f32x4*)sc + lane + 64 * j);
        const f32x4 y = v[j] * rinv * (b + 1.f) + a; u32x2 w; w.x = cvt_pk_bf16(y.x, y.y); w.y = cvt_pk_bf16(y.z, y.w); o8[64 * j] = w; }
}

__global__ void __launch_bounds__(512) mk_fwd(Params P) {
    extern __shared__ __attribute__((aligned(16))) unsigned char lds[];
    cg::grid_group grid = cg::this_grid();
    const int G = gridDim.x;
    unsigned bar_target = 0;
#define GRID_SYNC() do { if (ph == 0) { grid.sync(); if (threadIdx.x == 0) (void)xb_add((unsigned*)(P.ws + WS_XB) + XB_XCNT(xb_xcc_id()), 1u); } else grid_bar((unsigned*)(P.ws + WS_XB), (volatile LAS unsigned*)((LAS unsigned char*)lds + LDS_BYTES - 16), threadIdx.x); } while (0)

    constexpr int NPH = 2 + 44 + 1;
    for (int ph = 0; ph < NPH; ++ph) {
        int tid = threadIdx.x; asm volatile("" : "+v"(tid));
        int bid = blockIdx.x; asm volatile("" : "+s"(bid));
        unsigned char* ws = P.ws; asm volatile("" : "+s"(ws));
        const int lane = tid & 63, wave = __builtin_amdgcn_readfirstlane(tid >> 6), gw = bid * 8 + wave, NGW = G * 8;
        float* const H = (float*)(ws + WS_H); bf16_t* const XN = (bf16_t*)(ws + WS_XN); float* const MOD = (float*)(ws + WS_MOD); float* const MODP = (float*)(ws + WS_MODP);
        float* const LBV = (float*)(ws + WS_LBV); float* const ROPE = (float*)(ws + WS_ROPE);
        unsigned char* const BIG = ws + WS_BIG;
        const int l = (ph - 2) / 11, step = ph < 2 ? -1 : (ph == NPH - 1 ? -2 : (ph - 2) % 11);
        if (ph == 0) {
            const f32x4* x4 = (const f32x4*)P.in[0]; const f32x4* c4 = (const f32x4*)P.in[2]; f32x4* h4 = (f32x4*)H;
            for (size_t i = (size_t)bid * 512 + tid; i < (size_t)M * 256; i += (size_t)G * 512) {
                const int row = (int)(i >> 8), c = (int)(i & 255), bi = row / TB, rr = row - bi * TB;
                h4[i] = __builtin_nontemporal_load(rr < CTXL ? &c4[((size_t)bi * CTXL + rr) * 256 + c] : &x4[((size_t)bi * SEQ + (rr - CTXL)) * 256 + c]);
            }
            for (int e = bid * 512 + tid; e < 64 * 112; e += G * 512) {
                int pos, j, nq; size_t off;
                if (e < 64 * 16) { nq = 16; pos = e / 16; j = e % 16; off = ROPE16 + (size_t)e * 2; }
                else if (e < 64 * 48) { const int q = e - 64 * 16; nq = 32; pos = q / 32; j = q % 32; off = ROPE32 + (size_t)q * 2; }
                else { const int q = e - 64 * 48; nq = 64; pos = q / 64; j = q % 64; off = ROPE64 + (size_t)q * 2; }
                const float inv = exp2f(-(float)j / (float)nq * 13.287712379549449f);
                float sn, cs; sincos_cw((float)pos * inv, sn, cs);
                ROPE[off] = cs; ROPE[off + 1] = sn;
            }
            if (bid == 0) for (int i = tid; i < XB_WORDS; i += 512) __hip_atomic_store((unsigned*)(ws + WS_XB) + i, 0u, __ATOMIC_RELAXED, __HIP_MEMORY_SCOPE_AGENT);
            if (tid < 4) ((volatile LAS unsigned*)((LAS unsigned char*)lds + LDS_BYTES - 16))[tid] = 0u;
            float* cond = (float*)lds; float* red = cond + 5 * 1024;
            for (int i = tid; i < 5120; i += 512) { const int r = i >> 10, k = i & 1023; const float x = r < 4 ? P.in[1][r * 1024 + k] : P.in[3][k]; cond[i] = siluf(x); }
            __syncthreads();
            for (int unit = bid; unit < 1152; unit += G) {
                const int ks = unit & 7, cgp = (unit >> 3) % 36, ll = unit / 288;
                const float* W = P.in[4] + (size_t)ll * DM * NMOD + cgp * 256 + lane * 4;
                const int kbase = ks * 128 + wave * 16;
                f32x4 a[5];
#pragma unroll
                for (int r = 0; r < 5; ++r) a[r] = (f32x4){0.f, 0.f, 0.f, 0.f};
#pragma unroll 4
                for (int kk = 0; kk < 16; ++kk) { const int k = kbase + kk; const f32x4 w = __builtin_nontemporal_load((const f32x4*)(W + (size_t)k * NMOD));
#pragma unroll
                    for (int r = 0; r < 5; ++r) a[r] += w * cond[r * 1024 + k]; }
#pragma unroll
                for (int r = 0; r < 5; ++r) *(f32x4*)(red + (wave * 5 + r) * 256 + lane * 4) = a[r];
                __syncthreads();
                for (int o = tid; o < 1280; o += 512) { const int r = o >> 8, cc = o & 255; float sum = 0.f;
#pragma unroll
                    for (int w = 0; w < 8; ++w) sum += red[(w * 5 + r) * 256 + cc];
                    MODP[(size_t)((ks * 4 + ll) * 5 + r) * NMOD + cgp * 256 + cc] = sum; }
                __syncthreads();
            }
        } else if (ph == 1) {
            for (int i = bid * 512 + tid; i < 4 * 5 * NMOD; i += G * 512) { const int ll = i / (5 * NMOD), n = i % NMOD; float sum = P.in[5][ll * NMOD + n];
#pragma unroll
                for (int ks = 0; ks < 8; ++ks) sum += MODP[(size_t)ks * (4 * 5 * NMOD) + i];
                MOD[i] = sum; }
            for (int c = bid * 512 + tid; c < 1024; c += G * 512) { const float* lb = P.in[19]; const float a0 = lb[c], a1 = lb[1024 + c], a2 = lb[2048 + c], a3 = lb[3072 + c];
                const float mx = fmaxf(fmaxf(a0, a1), fmaxf(a2, a3)); const float e0 = __expf(a0 - mx), e1 = __expf(a1 - mx), e2 = __expf(a2 - mx), e3 = __expf(a3 - mx);
                LBV[c] = (e1 + e2) / (e0 + e1 + e2 + e3); }
        } else if (step == -2) {
            for (int r = gw; r < NB * SEQ; r += NGW) { const int bi = r >> 12, t = r & 4095; const size_t row = (size_t)bi * TB + CTXL + t;
                const f32x4* xr = (const f32x4*)(H + row * DM) + lane; f32x4 v[4]; float s = 0.f;
#pragma unroll
                for (int j = 0; j < 4; ++j) { v[j] = xr[64 * j]; s += (v[j].x * v[j].x + v[j].y * v[j].y) + (v[j].z * v[j].z + v[j].w * v[j].w); }
                const float rinv = rsqrtf(wave_sum(s) * (1.f / DM) + EPS);
                f32x4* op = (f32x4*)(P.out + (size_t)r * DM) + lane; const f32x4* gp = (const f32x4*)P.in[25] + lane;
#pragma unroll
                for (int j = 0; j < 4; ++j) __builtin_nontemporal_store(v[j] * rinv * gp[64 * j], &op[64 * j]); }
        } else if (step == 0 || step == 3 || step == 8) {
            const float* modn = MOD + (size_t)l * 5 * NMOD + step * DM - (step == 8 ? 2 * DM : 0);
            const int ns = step == 0 ? (l == 0 ? 0 : 11) : step == 3 ? 11 : (l == 3 ? 0 : l == 1 ? 8 : 4);
            const float* PART = (const float*)(BIG + 3 * U1);
            for (int row = gw; row < M; row += NGW) {
                const int bi = row / TB, rr = row - bi * TB, mrow = rr < CTXL ? 4 : bi;
                const float* sh = modn + (size_t)mrow * NMOD;
                f32x4* hr = (f32x4*)(H + (size_t)row * DM) + lane; f32x4 v[4];
#pragma unroll
                for (int j = 0; j < 4; ++j) v[j] = hr[64 * j];
                if (ns && rr < CTXL) {
                    for (int sp = 0; sp < ns; ++sp) { const f32x4* pr = (const f32x4*)(PART + ((size_t)sp * 1024 + bi * 256 + rr) * DM) + lane;
#pragma unroll
                        for (int j = 0; j < 4; ++j) v[j] += pr[64 * j]; }
#pragma unroll
                    for (int j = 0; j < 4; ++j) hr[64 * j] = v[j];
                }
                norm_row(v, sh, sh + DM, XN + (size_t)row * DM, lane);
            }
            if (step == 0) {
                float* scr = (float*)lds + wave * (64 * 33);
                const float* win; const float* wout; int nin, kout, ptin;
                if (l == 0) { win = P.in[10]; wout = P.in[11]; nin = 3072; kout = 1024; ptin = 2; }
                else if (l == 1) { win = P.in[14]; wout = P.in[15]; nin = 6144; kout = 2048; ptin = 3; }
                else if (l == 2) { win = P.in[17]; wout = P.in[18]; nin = 5120; kout = 1024; ptin = 0; }
                else { win = P.in[21]; wout = P.in[22]; nin = 1536; kout = 1024; ptin = 0; }
                const int I13 = (DM / 64) * (2 * FF / 32), I2 = (FF / 64) * (DM / 32), IIN = (DM / 64) * (nin / 32), IOUT = (kout / 64) * (DM / 32);
                const int NIT = 2 * I13 + 2 * I2 + IIN + IOUT;
                for (int it = gw; it < NIT; it += NGW) {
                    int r = it; const float* W; int K, N, pt; bf16_t* WT;
                    if (r < 2 * I13) { const int sel = r >= I13; r -= sel * I13; W = P.in[sel ? 8 : 6] + (size_t)l * DM * 2 * FF; K = DM; N = 2 * FF; pt = 1; WT = (bf16_t*)(ws + (sel ? WS_W13B : WS_W13A)); }
                    else if ((r -= 2 * I13) < 2 * I2) { const int sel = r >= I2; r -= sel * I2; W = P.in[sel ? 9 : 7] + (size_t)l * FF * DM; K = FF; N = DM; pt = 0; WT = (bf16_t*)(ws + (sel ? WS_W2B : WS_W2A)); }
                    else if ((r -= 2 * I2) < IIN) { W = win; K = DM; N = nin; pt = ptin; WT = (bf16_t*)(ws + WS_WIN); }
                    else { r -= IIN; W = wout; K = kout; N = DM; pt = 0; WT = (bf16_t*)(ws + WS_WOUT); }
                    transpose_item(W, K, N, WT, pt, scr, r, lane);
                }
            }
        } else if (step == 1 || step == 2 || step == 4 || step == 7 || step == 9 || step == 10) {
            pg8::EpiAll E{}; pg8::Gemm g{}; int nN, lat = 0, resid = 0; E.ws = ws;
            if (step == 1 || step == 9) { E.kind = pg8::K_SWIGLU; g.A = XN; g.Bt = (const bf16_t*)(ws + (step == 1 ? WS_W13A : WS_W13B)); g.K = DM; nN = 22; lat = (step == 9 && l == 3); }
            else if (step == 2 || step == 10) { E.kind = pg8::K_RESID; E.aux = l * 16 + (step == 2 ? 2 : 8); g.A = (const bf16_t*)BIG; g.Bt = (const bf16_t*)(ws + (step == 2 ? WS_W2A : WS_W2B)); g.K = FF; nN = 4; lat = 1; resid = (step == 10 && l == 3) ? 1 : 2; }
            else if (step == 7) { E.kind = pg8::K_RESID; E.aux = l * 16 + 5; g.Bt = (const bf16_t*)(ws + WS_WOUT); nN = 4; lat = 1; resid = (l == 3) ? 1 : 2;
                g.A = (const bf16_t*)(BIG + (l == 0 ? 6 * U1 : l == 1 ? 4 * U1 : l == 2 ? 9 * U1 : 7 * U1)); g.K = (l == 1) ? 2048 : DM; }
            else { g.A = XN; g.Bt = (const bf16_t*)(ws + WS_WIN); g.K = DM;
                if (l == 0) { E.kind = pg8::K_DIFF; nN = 12; } else if (l == 1) { E.kind = pg8::K_RET; nN = 24; } else if (l == 2) { E.kind = pg8::K_HGRN; nN = 20; } else { E.kind = pg8::K_GQA; nN = 6; } }
            const int npass = resid == 2 ? 2 : 1;
            for (int pass = 0; pass < npass; ++pass) {
                pg8::Order S; g.nt = pass ? 4 : g.K / 64; if (pass) E.kind = pg8::K_PART;
                S.init(lat ? 64 : 68, nN, G, bid, pass ? 2 : lat, g.K / 256);
                pg8::gemm_phase<pg8::EpiAll, pg8::Order>((LAS unsigned char*)lds, g, S, E, tid);
            }
        } else if ((step == 5 && l == 0) || (step == 6 && l == 3)) {
            const bool df = (l == 0);
            const bf16_t* Qp = (const bf16_t*)(BIG + (df ? 0 : 3 * U1)); const bf16_t* Kp = (const bf16_t*)(BIG + (df ? 2 * U1 : 5 * U1)); const bf16_t* Vp = (const bf16_t*)(BIG + (df ? 3 * U1 : 6 * U1));
            bf16_t* Op = (bf16_t*)(BIG + (df ? 4 * U1 : 7 * U1));
            const int nun = df ? 1088 : 512; const float scale = df ? 1.0f : 0.08838834764831845f;
            for (int L = bid; L < nun; L += G) {
                int bq, hm, qb, seq, kvh;
                if (df) { if (L < 1024) { qb = (L & 15) + 1; hm = (L >> 4) & 15; bq = L >> 8; seq = TB; } else { const int L2 = L - 1024; hm = L2 & 15; bq = L2 >> 4; qb = 0; seq = CTXL; } kvh = hm >> 1; }
                else { qb = (L & 15) + 1; hm = (L >> 4) & 7; bq = L >> 7; seq = TB; kvh = hm >> 2; }
                const size_t r0 = (size_t)bq * TB + qb * 256;
                const size_t qoff = r0 * 2048 + hm * 128, koff = (size_t)bq * TB * 1024 + kvh * 128, ooff = (size_t)(hm >> 3) * ((size_t)M * 1024) + r0 * 1024 + (hm & 7) * 128;
                if (!df) att::attn_dense_body<0>(Qp + qoff, Kp + koff, Vp + koff, Op + ooff, seq, scale, (char*)lds, tid);
                else if (hm & 1) att::attn_dense_body<2>(Qp + qoff, Kp + koff, Vp + koff, Op + ooff, seq, scale, (char*)lds, tid);
                else att::attn_dense_body<1>(Qp + qoff, Kp + koff, Vp + koff, Op + ooff, seq, scale, (char*)lds, tid);
                __syncthreads();
            }
        } else if (step == 6 && l == 0) {
            const bf16_t* Ob = (const bf16_t*)(BIG + 4 * U1); bf16_t* A2b = (bf16_t*)(BIG + 6 * U1);
            const float* lam = P.in[12]; const float la = lam[lane] * lam[64 + lane], lb2 = lam[128 + lane] * lam[192 + lane];
            const float lam_full = __expf(wave_sum(la)) - __expf(wave_sum(lb2)) + 0.2f;
            const int hh = lane >> 3, v0 = (lane & 7) * 16;
            for (int row = gw; row < M; row += NGW) {
                const bf16_t* p0 = Ob + (size_t)(hh >> 2) * ((size_t)M * 1024) + (size_t)row * 1024 + ((2 * hh) & 7) * 128 + v0; const bf16_t* p1 = p0 + 128;
                const bf16x8 a0 = __builtin_nontemporal_load((const bf16x8*)p0), a1 = __builtin_nontemporal_load((const bf16x8*)(p0 + 8)), b0 = __builtin_nontemporal_load((const bf16x8*)p1), b1 = __builtin_nontemporal_load((const bf16x8*)(p1 + 8));
                float o[16]; float s = 0.f;
#pragma unroll
                for (int e = 0; e < 8; ++e) { o[e] = bf2f((bf16_t)a0[e]) - lam_full * bf2f((bf16_t)b0[e]); o[8 + e] = bf2f((bf16_t)a1[e]) - lam_full * bf2f((bf16_t)b1[e]); }
#pragma unroll
                for (int e = 0; e < 16; ++e) s += o[e] * o[e];
                s += __shfl_xor(s, 1); s += __shfl_xor(s, 2); s += __shfl_xor(s, 4);
                const float rinv = rsqrtf(s * (1.f / 128.f) + EPS) * 0.8f;
#pragma unroll
                for (int e = 0; e < 16; ++e) o[e] = o[e] * rinv * P.in[13][v0 + e];
                bf16_t* dp = A2b + (size_t)row * 1024 + hh * 128 + v0;
                *(u32x4*)dp = pack8(o); *(u32x4*)(dp + 8) = pack8(o + 8);
            }
        } else if (step == 5 && l == 1) {
            const bf16_t* Qb = (const bf16_t*)BIG; const bf16_t* Kb = (const bf16_t*)(BIG + U1); const bf16_t* Vb = (const bf16_t*)(BIG + 2 * U1); bf16_t* OF = (bf16_t*)(BIG + 6 * U1); bf16_t* OB = (bf16_t*)(BIG + 8 * U1);
            for (int L = bid; L < 256; L += G) {
                const int slice = L & 7, dir = (L >> 3) & 1, hh = (L >> 4) & 3, bq = L >> 6;
                const float lg = __logf(1.f - exp2f(-P.in[16][dir * 4 + hh]));
                gla_unit<256, 64, true>(lds, bq, hh, dir, slice, Qb, Kb, Vb, nullptr, dir ? OB : OF, lg, 2048, hh * 512 + slice * 64, tid);
            }
        } else if (step == 6 && l == 1) {
            bf16_t* Gb = (bf16_t*)(BIG + 4 * U1); const bf16_t* OF = (const bf16_t*)(BIG + 6 * U1); const bf16_t* OB = (const bf16_t*)(BIG + 8 * U1);
            for (int row = gw; row < M; row += NGW) {
#pragma unroll
                for (int hh = 0; hh < 4; ++hh) { const size_t off = (size_t)row * 2048 + hh * 512 + lane * 8;
                    const bf16x8 a = __builtin_nontemporal_load((const bf16x8*)(OF + off)), b = __builtin_nontemporal_load((const bf16x8*)(OB + off)), gt = *(const bf16x8*)(Gb + off);
                    float o[8]; float s = 0.f;
#pragma unroll
                    for (int e = 0; e < 8; ++e) { o[e] = bf2f((bf16_t)a[e]) + bf2f((bf16_t)b[e]); s += o[e] * o[e]; }
                    const float rinv = rsqrtf(wave_sum(s) * (1.f / 512.f) + EPS);
#pragma unroll
                    for (int e = 0; e < 8; ++e) o[e] = o[e] * rinv * bf2f((bf16_t)gt[e]);
                    *(u32x4*)(Gb + off) = pack8(o); }
            }
        } else if (step == 5 && l == 2) {
            const bf16_t* Qb = (const bf16_t*)BIG; const bf16_t* Vb = (const bf16_t*)(BIG + U1); const float* LF = (const float*)(BIG + 3 * U1); bf16_t* OF = (bf16_t*)(BIG + 7 * U1); bf16_t* OB = (bf16_t*)(BIG + 8 * U1);
            for (int L = bid; L < 256; L += G) {
                const int slice = L & 3, dir = (L >> 2) & 1, hh = (L >> 3) & 7, bq = L >> 6;
                gla_unit<128, 32, false>(lds, bq, hh, dir, slice, Qb, nullptr, Vb, LF, dir ? OB : OF, 0.f, 1024, hh * 128 + slice * 32, tid);
            }
        } else if (step == 6 && l == 2) {
            const bf16_t* Gb = (const bf16_t*)(BIG + 2 * U1); const bf16_t* OF = (const bf16_t*)(BIG + 7 * U1); const bf16_t* OB = (const bf16_t*)(BIG + 8 * U1); bf16_t* A2b = (bf16_t*)(BIG + 9 * U1);
            const int v0 = (lane & 7) * 16;
            for (int row = gw; row < M; row += NGW) { const size_t off = (size_t)row * 1024 + lane * 16;
                const bf16x8 a0 = __builtin_nontemporal_load((const bf16x8*)(OF + off)), a1 = __builtin_nontemporal_load((const bf16x8*)(OF + off + 8)), b0 = __builtin_nontemporal_load((const bf16x8*)(OB + off)), b1 = __builtin_nontemporal_load((const bf16x8*)(OB + off + 8));
                const bf16x8 g0 = *(const bf16x8*)(Gb + off), g1 = *(const bf16x8*)(Gb + off + 8);
                float o[16]; float s = 0.f;
#pragma unroll
                for (int e = 0; e < 8; ++e) { o[e] = bf2f((bf16_t)a0[e]) + bf2f((bf16_t)b0[e]); o[8 + e] = bf2f((bf16_t)a1[e]) + bf2f((bf16_t)b1[e]); }
#pragma unroll
                for (int e = 0; e < 16; ++e) s += o[e] * o[e];
                s += __shfl_xor(s, 1); s += __shfl_xor(s, 2); s += __shfl_xor(s, 4);
                const float rinv = rsqrtf(s * (1.f / 128.f) + EPS);
#pragma unroll
                for (int e = 0; e < 8; ++e) { o[e] = o[e] * rinv * P.in[20][v0 + e] * bf2f((bf16_t)g0[e]); o[8 + e] = o[8 + e] * rinv * P.in[20][v0 + 8 + e] * bf2f((bf16_t)g1[e]); }
                *(u32x4*)(A2b + off) = pack8(o); *(u32x4*)(A2b + off + 8) = pack8(o + 8); }
        } else if (step == 5 && l == 3) {
            const float* QKR = (const float*)BIG; bf16_t* Qb = (bf16_t*)(BIG + 3 * U1); bf16_t* Kb = (bf16_t*)(BIG + 5 * U1);
            const float* tab = ROPE + ROPE32; const int jj = lane & 31;
            const float gq0 = P.in[23][lane], gq1 = P.in[23][lane + 64], gk0 = P.in[24][lane], gk1 = P.in[24][lane + 64];
            for (int it = gw; it < M * 10; it += NGW) { const int row = it / 10, slot = it - row * 10; const int bi = row / TB, rr = row - bi * TB;
                const float* src = QKR + (size_t)row * 1280 + slot * 128;
                float x0 = __builtin_nontemporal_load(&src[lane]), x1 = __builtin_nontemporal_load(&src[lane + 64]);
                const float rinv = rsqrtf(wave_sum(x0 * x0 + x1 * x1) * (1.f / 128.f) + EPS);
                x0 = x0 * rinv * (slot < 8 ? gq0 : gk0); x1 = x1 * rinv * (slot < 8 ? gq1 : gk1);
                if (rr >= CTXL) { const int t = rr - CTXL, pr = t >> 6, pc = t & 63;
                    const float c0 = tab[(pr * 32 + jj) * 2], s0 = tab[(pr * 32 + jj) * 2 + 1], c1 = tab[(pc * 32 + jj) * 2], s1 = tab[(pc * 32 + jj) * 2 + 1];
                    const float y0 = __shfl_xor(x0, 32), y1 = __shfl_xor(x1, 32);
                    x0 = lane < 32 ? x0 * c0 - y0 * s0 : x0 * c0 + y0 * s0;
                    x1 = lane < 32 ? x1 * c1 - y1 * s1 : x1 * c1 + y1 * s1; }
                bf16_t* dst = slot < 8 ? Qb + (size_t)row * 2048 + slot * 128 : Kb + (size_t)row * 1024 + (slot - 8) * 128;
                dst[lane] = f2bf(x0); dst[lane + 64] = f2bf(x1); }
        }
        if (ph + 1 < NPH) GRID_SYNC();
    }
}

extern "C" void kernel_launch(void* const* d_in, const int* in_sizes, int n_in, void* d_out, int out_size, void* d_ws, size_t ws_size, hipStream_t stream) {
    static int grid = 0;
    if (grid == 0) {
        if (n_in != 26 || out_size != NB * SEQ * DM || ws_size < WS_END) { fprintf(stderr, "kernel_launch: unexpected shapes (n_in %d out %d ws %zu need %zu)\n", n_in, out_size, ws_size, (size_t)WS_END); grid = -1; return; }
        int dev = 0, cus = 0, per_cu = 0;
        if (hipGetDevice(&dev) != hipSuccess || hipDeviceGetAttribute(&cus, hipDeviceAttributeMultiprocessorCount, dev) != hipSuccess) { grid = -1; return; }
        if (hipFuncSetAttribute((const void*)mk_fwd, hipFuncAttributeMaxDynamicSharedMemorySize, LDS_BYTES) != hipSuccess) { fprintf(stderr, "kernel_launch: hipFuncSetAttribute failed\n"); grid = -1; return; }
        if (hipOccupancyMaxActiveBlocksPerMultiprocessor(&per_cu, (const void*)mk_fwd, 512, LDS_BYTES) != hipSuccess || per_cu < 1) { fprintf(stderr, "kernel_launch: occupancy query says %d\n", per_cu); per_cu = 1; }
        (void)hipGetLastError();
        grid = cus;
    }
    if (grid < 0) return;
    Params p{};
    for (int i = 0; i < 26; ++i) p.in[i] = (const float*)d_in[i];
    p.out = (float*)d_out; p.ws = (unsigned char*)d_ws;
    void* args[] = {&p};
    hipError_t e = hipLaunchCooperativeKernel((const void*)mk_fwd, dim3(grid), dim3(512), args, LDS_BYTES, stream);
    if (e != hipSuccess) fprintf(stderr, "cooperative launch failed: %s (grid %d)\n", hipGetErrorString(e), grid);
}
```

```cpp
#include <hip/hip_runtime.h>
#include <hip/hip_cooperative_groups.h>
#include <cstdio>
#include <cstdint>
namespace cg = cooperative_groups;

#define LAS __attribute__((address_space(3)))
#define GAS __attribute__((address_space(1)))
typedef unsigned short bf16_t;
typedef short bf16x8 __attribute__((ext_vector_type(8)));
typedef short s16x4 __attribute__((ext_vector_type(4)));
typedef float f32x4 __attribute__((ext_vector_type(4)));
typedef float f32x2 __attribute__((ext_vector_type(2)));
typedef float f32x16 __attribute__((ext_vector_type(16)));
typedef unsigned u32x4 __attribute__((ext_vector_type(4)));
typedef unsigned u32x2 __attribute__((ext_vector_type(2)));

constexpr int NB = 4, SEQ = 4096, CTXL = 256, TB = SEQ + CTXL  , M = NB * TB  , DM = 1024, FF = 2816, NMOD = 9 * DM;
constexpr float EPS = 1e-6f;

constexpr size_t al256(size_t x) { return (x + 255) / 256 * 256; }
constexpr size_t WS_H = 0;
constexpr size_t WS_XN = WS_H + (size_t)M * DM * 4;
constexpr size_t WS_MOD = WS_XN + (size_t)M * DM * 2;
constexpr size_t WS_MODP = WS_MOD + al256((size_t)4 * 5 * NMOD * 4);
constexpr size_t WS_LBV = WS_MODP + al256((size_t)8 * 4 * 5 * NMOD * 4);
constexpr size_t WS_ROPE = WS_LBV + 4096;
constexpr size_t ROPE16 = 0, ROPE32 = 64 * 16 * 2, ROPE64 = ROPE32 + 64 * 32 * 2;
constexpr size_t WS_BAR = WS_ROPE + 65536 - 256;
constexpr size_t WS_XB = WS_ROPE + 65536;
constexpr size_t WS_W13A = WS_XB + 16384;
constexpr size_t WS_W2A = WS_W13A + (size_t)2 * FF * DM * 2;
constexpr size_t WS_W13B = WS_W2A + (size_t)FF * DM * 2;
constexpr size_t WS_W2B = WS_W13B + (size_t)2 * FF * DM * 2;
constexpr size_t WS_WIN = WS_W2B + (size_t)FF * DM * 2;
constexpr size_t WS_WOUT = WS_WIN + (size_t)6144 * DM * 2;
constexpr size_t WS_BIG = WS_WOUT + (size_t)2048 * DM * 2;
constexpr size_t U1 = (size_t)M * DM * 2;
constexpr size_t WS_END = WS_BIG + 10 * U1;

typedef __bf16 bf16x2_t __attribute__((ext_vector_type(2)));
__device__ __forceinline__ unsigned cvt_pk_bf16(float lo, float hi) { const f32x2 v = {lo, hi}; const bf16x2_t b = __builtin_convertvector(v, bf16x2_t); return __builtin_bit_cast(unsigned, b); }
__device__ __forceinline__ bf16_t f2bf(float x) { return (bf16_t)(cvt_pk_bf16(x, x) & 0xffffu); }
__device__ __forceinline__ float bf2f(bf16_t v) { return __uint_as_float((unsigned)v << 16); }
__device__ __forceinline__ float siluf(float x) { return x * __builtin_amdgcn_rcpf(1.f + __expf(-x)); }
__device__ __forceinline__ float wave_sum(float v) {
#pragma unroll
    for (int o = 1; o < 64; o <<= 1) v += __shfl_xor(v, o);
    return v;
}
__device__ __forceinline__ u32x4 pack8(const float* v) { u32x4 w; w.x = cvt_pk_bf16(v[0], v[1]); w.y = cvt_pk_bf16(v[2], v[3]); w.z = cvt_pk_bf16(v[4], v[5]); w.w = cvt_pk_bf16(v[6], v[7]); return w; }

namespace pg8 {
constexpr int BM = 256, BK = 64, HALF = 128, HTB = HALF * BK * 2, STAGE_BYTES = 8 * HTB, NXCD = 8, WGM = 8;
__host__ __device__ __forceinline__ int lds_byte(int r, int c) { const int st = (r >> 4) * 2 + (c >> 5), rr = r & 15, cc = c & 31, ob = rr * 64 + cc * 2; return st * 1024 + (ob ^ (((ob >> 9) & 1) << 5)); }
__host__ __device__ __forceinline__ void stage_rc(int b, int& R, int& C) { const int st = b / 1024, sb = b % 1024, swz = sb ^ (((sb >> 9) & 1) << 5); R = (st >> 1) * 16 + swz / 64; C = (st & 1) * 32 + (swz % 64) / 2; }
__host__ __device__ __forceinline__ int perm32(int rho) { const int n = rho >> 4, i = rho & 15; return 8 * (i >> 2) + 4 * n + (i & 3); }
struct Unit { int pm, pn, kb; };
struct Gemm { const bf16_t* A; const bf16_t* Bt; int K, nt; };
struct Order {
    int nM, nN, nwg, G, c, mode, nsplit;
    __device__ void init(int nM_, int nN_, int G_, int c_, int mode_, int nsplit_) { nM = nM_; nN = nN_; nwg = mode_ == 2 ? 16 * nsplit_ : nM * nN; G = G_; c = c_; mode = mode_; nsplit = nsplit_; }
    __device__ bool next(int i, Unit& u) const {
        const long L = (long)i * G + c; if (L >= nwg) return false;
        if (mode == 2) { const int sp = (int)L % nsplit, t = (int)L / nsplit; u.pn = t & 3; u.pm = 17 * (t >> 2); u.kb = sp * 512; return true; }
        int wgid = (int)L; { const int q = nwg / NXCD, r = nwg % NXCD, xcd = wgid % NXCD, off = wgid / NXCD; wgid = (xcd < r ? xcd * (q + 1) : r * (q + 1) + (xcd - r) * q) + off; }
        const int nig = WGM * nN, gid = wgid / nig, fm = gid * WGM, gsz = (nM - fm) < WGM ? (nM - fm) : WGM;
        u.pm = fm + ((wgid % nig) % gsz); u.pn = (wgid % nig) / gsz; u.kb = 0;
        if (mode == 1) u.pm = u.pm + u.pm / 16 + 1;
        return true;
    }
};

enum { K_SWIGLU = 0, K_RESID = 1, K_DIFF = 2, K_RET = 3, K_HGRN = 4, K_GQA = 5, K_PART = 6 };
struct EpiAll {
    static constexpr bool PERM = true;
    int kind, aux;
    unsigned char* ws;
    __device__ __forceinline__ void plain(const f32x4 (&acc)[2][2][4][2], int row0, int wc, int fq, bf16_t* dst, int ld, int colbase, int act) const {
#pragma unroll
        for (int ai = 0; ai < 2; ++ai)
#pragma unroll
            for (int m = 0; m < 4; ++m) { bf16_t* rp = dst + (size_t)(row0 + ai * 128 + m * 16) * ld + colbase + wc * 32 + 8 * fq;
#pragma unroll
                for (int bj = 0; bj < 2; ++bj) { float v[8];
#pragma unroll
                    for (int e = 0; e < 8; ++e) { float x = acc[ai][bj][m][e >> 2][e & 3]; v[e] = act ? siluf(x) : x; }
                    *(u32x4*)(rp + bj * 128) = pack8(v); }
                asm volatile("" ::: "memory"); }
    }
    template <int NQ> __device__ __forceinline__ void roped(const float* rope, const f32x4 (&acc)[2][2][4][2], int row0, bool is_ctx, int rowb  , int axis, int j0,
                                                             bf16_t* dst, int ld, int c1, int dx2, float sc, int cz  ) const {
#pragma unroll
        for (int ai = 0; ai < 2; ++ai)
#pragma unroll
            for (int m = 0; m < 4; ++m) { const int row = row0 + ai * 128 + m * 16; float y1[8], y2[8];
                if (!is_ctx) { const int t = row - rowb, pos = axis ? (t & 63) : (t >> 6); const f32x4* tp = (const f32x4*)(rope + (size_t)(pos * NQ + j0) * 2);
#pragma unroll
                    for (int q = 0; q < 4; ++q) { const f32x4 cs = tp[q];
#pragma unroll
                        for (int hh = 0; hh < 2; ++hh) { const int e = 2 * q + hh; const float c = hh ? cs[2] : cs[0], s = hh ? cs[3] : cs[1];
                            const float x1 = acc[ai][0][m][e >> 2][e & 3], x2 = acc[ai][1][m][e >> 2][e & 3];
                            y1[e] = (x1 * c - x2 * s) * sc; y2[e] = (x2 * c + x1 * s) * sc; } }
                } else {
#pragma unroll
                    for (int e = 0; e < 8; ++e) { y1[e] = acc[ai][0][m][e >> 2][e & 3] * sc; y2[e] = acc[ai][1][m][e >> 2][e & 3] * sc; }
                }
                bf16_t* rp = dst + (size_t)row * ld;
                *(u32x4*)(rp + c1) = pack8(y1); *(u32x4*)(rp + c1 + dx2) = pack8(y2);
                if (cz >= 0) { const u32x4 z = {0u, 0u, 0u, 0u}; *(u32x4*)(rp + cz) = z; *(u32x4*)(rp + cz + dx2) = z; }
                asm volatile("" ::: "memory"); }
    }
    __device__ __forceinline__ void operator()(const f32x4 (&acc)[2][2][4][2], const Unit& u, int wr, int wc, int fr, int fq) const {
        asm volatile("" : "+v"(fr), "+v"(fq));
        const int row0 = u.pm * BM + wr * 64 + fr;
        const int batch = u.pm / 17; const bool is_ctx = (u.pm % 17) == 0; const int rowb = batch * TB + CTXL;
        unsigned char* const BIG = ws + WS_BIG;
        if (kind == K_SWIGLU) {
            bf16_t* o0 = (bf16_t*)BIG;
#pragma unroll
            for (int ai = 0; ai < 2; ++ai)
#pragma unroll
                for (int m = 0; m < 4; ++m) { float v[8];
#pragma unroll
                    for (int e = 0; e < 8; ++e) v[e] = siluf(acc[ai][0][m][e >> 2][e & 3]) * acc[ai][1][m][e >> 2][e & 3];
                    *(u32x4*)(o0 + (size_t)(row0 + ai * 128 + m * 16) * FF + u.pn * 128 + wc * 32 + 8 * fq) = pack8(v);
                    asm volatile("" ::: "memory"); }
        } else if (kind == K_RESID) {
            const int mrow = is_ctx ? 4 : batch; const int col0 = u.pn * BM + wc * 32 + 8 * fq; const int gidx = aux & 15, ll = aux >> 4;
            const float gs = gidx == 5 ? 1.f : 0.5f; float* f0 = (float*)(ws + WS_H);
            const float* g = (const float*)(ws + WS_MOD) + (size_t)(ll * 5 + mrow) * NMOD + gidx * DM + col0;
            f32x4 gv[2][2];
#pragma unroll
            for (int bj = 0; bj < 2; ++bj)
#pragma unroll
                for (int n = 0; n < 2; ++n) gv[bj][n] = *(const f32x4*)(g + bj * 128 + 4 * n) * gs;
#pragma unroll
            for (int ai = 0; ai < 2; ++ai)
#pragma unroll
                for (int m = 0; m < 4; ++m) { float* hp = f0 + (size_t)(row0 + ai * 128 + m * 16) * DM + col0;
#pragma unroll
                    for (int bj = 0; bj < 2; ++bj)
#pragma unroll
                        for (int n = 0; n < 2; ++n) { f32x4 h = *(f32x4*)(hp + bj * 128 + 4 * n); h += gv[bj][n] * acc[ai][bj][m][n]; *(f32x4*)(hp + bj * 128 + 4 * n) = h; }
                    asm volatile("" ::: "memory"); }
        } else if (kind == K_PART) {
            const int col0 = u.pn * BM + wc * 32 + 8 * fq; const int gidx = aux & 15, ll = aux >> 4; const float gs = gidx == 5 ? 1.f : 0.5f;
            const float* g = (const float*)(ws + WS_MOD) + (size_t)(ll * 5 + 4) * NMOD + gidx * DM + col0;
            float* part = (float*)(BIG + 3 * U1) + ((size_t)(u.kb >> 9) * 1024 + batch * 256 + (row0 - batch * TB)) * DM + col0;
            f32x4 gv[2][2];
#pragma unroll
            for (int bj = 0; bj < 2; ++bj)
#pragma unroll
                for (int n = 0; n < 2; ++n) gv[bj][n] = *(const f32x4*)(g + bj * 128 + 4 * n) * gs;
#pragma unroll
            for (int ai = 0; ai < 2; ++ai)
#pragma unroll
                for (int m = 0; m < 4; ++m) { float* pp = part + (size_t)(ai * 128 + m * 16) * DM;
#pragma unroll
                    for (int bj = 0; bj < 2; ++bj)
#pragma unroll
                        for (int n = 0; n < 2; ++n) *(f32x4*)(pp + bj * 128 + 4 * n) = gv[bj][n] * acc[ai][bj][m][n];
                    asm volatile("" ::: "memory"); }
        } else if (kind == K_DIFF) {
            const float* rope = (const float*)(ws + WS_ROPE) + ROPE16;
            if (u.pn < 8) { const int axis = fq >> 1, j0 = (fq & 1) * 8;
                if (u.pn < 4) { const int ug = u.pn * 4 + wc; roped<16>(rope, acc, row0, is_ctx, rowb, axis, j0, (bf16_t*)BIG, 2048, ug * 128 + (ug & 1) * 64 + axis * 32 + j0, 16, 0.125f, ug * 128 + ((ug & 1) ^ 1) * 64 + axis * 32 + j0); }
                else roped<16>(rope, acc, row0, is_ctx, rowb, axis, j0, (bf16_t*)(BIG + 2 * U1), 1024, (u.pn - 4) * 256 + wc * 64 + axis * 32 + j0, 16, 1.f, -1);
            } else plain(acc, row0, wc, fq, (bf16_t*)(BIG + 3 * U1), 1024, (u.pn - 8) * 256, 0);
        } else if (kind == K_RET) {
            const float* rope = (const float*)(ws + WS_ROPE) + ROPE64;
            if (u.pn < 8) { const int axis = wc >> 1, j0 = (wc & 1) * 32 + 8 * fq;
                if (u.pn < 4) roped<64>(rope, acc, row0, is_ctx, rowb, axis, j0, (bf16_t*)BIG, 1024, u.pn * 256 + axis * 128 + j0, 64, 1.f, -1);
                else roped<64>(rope, acc, row0, is_ctx, rowb, axis, j0, (bf16_t*)(BIG + U1), 1024, (u.pn - 4) * 256 + axis * 128 + j0, 64, 0.0625f, -1);
            } else if (u.pn < 16) plain(acc, row0, wc, fq, (bf16_t*)(BIG + 2 * U1), 2048, (u.pn - 8) * 256, 0);
            else plain(acc, row0, wc, fq, (bf16_t*)(BIG + 4 * U1), 2048, (u.pn - 16) * 256, 1);
        } else if (kind == K_HGRN) {
            if (u.pn < 4) plain(acc, row0, wc, fq, (bf16_t*)BIG, 1024, u.pn * 256, 1);
            else if (u.pn < 8) plain(acc, row0, wc, fq, (bf16_t*)(BIG + U1), 1024, (u.pn - 4) * 256, 0);
            else if (u.pn < 12) plain(acc, row0, wc, fq, (bf16_t*)(BIG + 2 * U1), 1024, (u.pn - 8) * 256, 1);
            else { const int cb = (u.pn - 12) * 256 + wc * 32 + 8 * fq; float* f0 = (float*)(BIG + 3 * U1); const float* lbv = (const float*)(ws + WS_LBV);
#pragma unroll
                for (int bj = 0; bj < 2; ++bj) { const int c = cb + bj * 128; f32x4 lb0 = *(const f32x4*)(lbv + (c & 1023)), lb1 = *(const f32x4*)(lbv + (c & 1023) + 4);
#pragma unroll
                    for (int ai = 0; ai < 2; ++ai)
#pragma unroll
                        for (int m = 0; m < 4; ++m) { float* rp = f0 + (size_t)(row0 + ai * 128 + m * 16) * 2048 + c; f32x4 r0, r1;
#pragma unroll
                            for (int i = 0; i < 4; ++i) { const float z0 = acc[ai][bj][m][0][i], z1 = acc[ai][bj][m][1][i];
                                const float s0 = __builtin_amdgcn_rcpf(1.f + __expf(-z0)), s1 = __builtin_amdgcn_rcpf(1.f + __expf(-z1));
                                r0[i] = __logf(lb0[i] + (1.f - lb0[i]) * s0); r1[i] = __logf(lb1[i] + (1.f - lb1[i]) * s1); }
                            *(f32x4*)rp = r0; *(f32x4*)(rp + 4) = r1; asm volatile("" ::: "memory"); } } }
        } else {
            if (u.pn < 5) { const int cb = u.pn * 256 + wc * 32 + 8 * fq; float* f0 = (float*)BIG;
#pragma unroll
                for (int ai = 0; ai < 2; ++ai)
#pragma unroll
                    for (int m = 0; m < 4; ++m) { float* rp = f0 + (size_t)(row0 + ai * 128 + m * 16) * 1280 + cb;
#pragma unroll
                        for (int bj = 0; bj < 2; ++bj) { *(f32x4*)(rp + bj * 128) = acc[ai][bj][m][0]; *(f32x4*)(rp + bj * 128 + 4) = acc[ai][bj][m][1]; } }
            } else plain(acc, row0, wc, fq, (bf16_t*)(BIG + 6 * U1), 1024, 0, 0);
        }
    }
};

template <class Epi, class Sched>
__device__ __forceinline__ void gemm_phase(LAS unsigned char* lds, const Gemm g, const Sched& S, const Epi& E, const int tid) {
    const int wid = __builtin_amdgcn_readfirstlane(tid >> 6), lane = tid & 63, wr = wid >> 2, wc = wid & 3, fr = lane & 15, fq = lane >> 4;
    const int K = g.K, nt = g.nt;
    unsigned voffA[2], voffB[2];
#pragma unroll
    for (int i = 0; i < 2; ++i) { int R, C; stage_rc(tid * 16 + i * 8192, R, C); const int Rb = Epi::PERM ? ((R & ~31) + perm32(R & 31)) : R;
        voffA[i] = (unsigned)(R * K + C) * 2u; voffB[i] = (unsigned)(Rb * K + C) * 2u; }
    const size_t kstep = (size_t)(BK * 2);
    const size_t hstep = (size_t)HALF * K * 2;
    const size_t tstep = 2 * hstep;
    const unsigned ldsw = (unsigned)wid * 1024u;
    const int aoff = lds_byte(wr * 64 + fr, fq * 8), boff = lds_byte(wc * 32 + fr, fq * 8);
#define PG8_SA(b, h) (((b) * 2 + (h)) * HTB)
#define PG8_SB(b, h) ((4 + (b) * 2 + (h)) * HTB)
#define PG8_STAGE(bufoff, gbase, voff) do { _Pragma("unroll") for (int _i = 0; _i < 2; ++_i) \
        __builtin_amdgcn_global_load_lds((const unsigned*)((const char*)(gbase) + (voff)[_i]), (LAS unsigned*)(lds + (bufoff) + ldsw + _i * 8192), 16, 0, 0); } while (0)
#define PG8_LDA(dst, b, h) do { _Pragma("unroll") for (int m = 0; m < 4; ++m) _Pragma("unroll") for (int k = 0; k < 2; ++k) dst[m][k] = *(const LAS bf16x8*)(lds + PG8_SA(b, h) + aoff + m * 2048 + k * 1024); } while (0)
#define PG8_LDB(dst, b, h) do { _Pragma("unroll") for (int n = 0; n < 2; ++n) _Pragma("unroll") for (int k = 0; k < 2; ++k) dst[n][k] = *(const LAS bf16x8*)(lds + PG8_SB(b, h) + boff + n * 2048 + k * 1024); } while (0)
#define PG8_MMA(ai, bj, At, Bt) do { __builtin_amdgcn_s_setprio(1); _Pragma("unroll") for (int m = 0; m < 4; ++m) _Pragma("unroll") for (int n = 0; n < 2; ++n) _Pragma("unroll") for (int k = 0; k < 2; ++k) \
        acc[ai][bj][m][n] = __builtin_amdgcn_mfma_f32_16x16x32_bf16(Bt[n][k], At[m][k], acc[ai][bj][m][n], 0, 0, 0); __builtin_amdgcn_s_setprio(0); } while (0)
#define PG8_WAIT_V(n) asm volatile("s_waitcnt vmcnt(" #n ")" ::: "memory")
#define PG8_WAIT_L(n) asm volatile("s_waitcnt lgkmcnt(" #n ")" ::: "memory")
#define PG8_BAR __builtin_amdgcn_s_barrier()
#define PG8_SCHED __builtin_amdgcn_sched_barrier(0)
    Unit cur, nxt; int ui = 0;
    if (!S.next(0, cur)) return;
    f32x4 acc[2][2][4][2];
#pragma unroll
    for (int a = 0; a < 2; ++a)
#pragma unroll
        for (int b = 0; b < 2; ++b)
#pragma unroll
            for (int m = 0; m < 4; ++m)
#pragma unroll
                for (int n = 0; n < 2; ++n) acc[a][b][m][n] = (f32x4){0.f, 0.f, 0.f, 0.f};
    bf16x8 At[4][2], B0[2][2], B1[2][2];
    const char* cA = (const char*)g.A + (size_t)cur.pm * tstep + cur.kb; const char* cB = (const char*)g.Bt + (size_t)cur.pn * tstep + cur.kb;
    PG8_STAGE(PG8_SB(0, 0), cB, voffB); PG8_STAGE(PG8_SB(0, 1), cB + hstep, voffB); PG8_STAGE(PG8_SA(0, 0), cA, voffA); PG8_STAGE(PG8_SA(0, 1), cA + hstep, voffA);
    if (wr == 1) PG8_BAR;
    PG8_WAIT_V(2); PG8_BAR;
    PG8_STAGE(PG8_SB(1, 0), cB + kstep, voffB); PG8_STAGE(PG8_SA(1, 0), cA + kstep, voffA); PG8_STAGE(PG8_SB(1, 1), cB + hstep + kstep, voffB);
    PG8_WAIT_V(6); PG8_BAR;
    for (;;) {
        const bool has_next = S.next(ui + 1, nxt);
        const char* nA = has_next ? (const char*)g.A + (size_t)nxt.pm * tstep + nxt.kb : cA; const char* nB = has_next ? (const char*)g.Bt + (size_t)nxt.pn * tstep + nxt.kb : cB;
        for (int t = 0; t < nt; t += 2) {
            const bool last = (t == nt - 2);
            const char* a1 = cA + (size_t)(t + 1) * kstep;
            const char* a2 = last ? nA : cA + (size_t)(t + 2) * kstep; const char* b2 = last ? nB : cB + (size_t)(t + 2) * kstep;
            const char* a3 = a2 + kstep; const char* b3 = b2 + kstep;
            PG8_LDB(B0, 0, 0); PG8_LDB(B1, 0, 1); PG8_SCHED; PG8_LDA(At, 0, 0); PG8_STAGE(PG8_SA(1, 1), a1 + hstep, voffA);
            PG8_WAIT_V(8); PG8_WAIT_L(0); PG8_BAR; PG8_MMA(0, 0, At, B0); PG8_MMA(0, 1, At, B1); PG8_BAR; PG8_SCHED;
            PG8_LDA(At, 0, 1); PG8_STAGE(PG8_SB(0, 0), b2, voffB); PG8_STAGE(PG8_SB(0, 1), b2 + hstep, voffB); PG8_STAGE(PG8_SA(0, 0), a2, voffA);
            PG8_WAIT_V(8); PG8_WAIT_L(0); PG8_BAR; PG8_MMA(1, 0, At, B0); PG8_MMA(1, 1, At, B1); PG8_BAR; PG8_SCHED;
            PG8_LDB(B0, 1, 0); PG8_LDB(B1, 1, 1); PG8_SCHED; PG8_LDA(At, 1, 0); PG8_STAGE(PG8_SA(0, 1), a2 + hstep, voffA);
            PG8_WAIT_V(8); PG8_WAIT_L(0); PG8_BAR; PG8_MMA(0, 0, At, B0); PG8_MMA(0, 1, At, B1); PG8_BAR; PG8_SCHED;
            PG8_LDA(At, 1, 1); PG8_STAGE(PG8_SB(1, 0), b3, voffB); PG8_STAGE(PG8_SB(1, 1), b3 + hstep, voffB); PG8_STAGE(PG8_SA(1, 0), a3, voffA);
            PG8_WAIT_V(8); PG8_WAIT_L(0); PG8_BAR; PG8_MMA(1, 0, At, B0); PG8_MMA(1, 1, At, B1); PG8_BAR; PG8_SCHED;
        }
        if (wr == 0) PG8_BAR;
        E(acc, cur, wr, wc, fr, fq);
        if (!has_next) break;
#pragma unroll
        for (int a = 0; a < 2; ++a)
#pragma unroll
            for (int b = 0; b < 2; ++b)
#pragma unroll
                for (int m = 0; m < 4; ++m)
#pragma unroll
                    for (int n = 0; n < 2; ++n) acc[a][b][m][n] = (f32x4){0.f, 0.f, 0.f, 0.f};
        cur = nxt; cA = nA; cB = nB; ++ui;
        if (wr == 1) PG8_BAR;
    }
    PG8_WAIT_V(0);
    PG8_BAR;
#undef PG8_SA
#undef PG8_SB
#undef PG8_STAGE
#undef PG8_LDA
#undef PG8_LDB
#undef PG8_MMA
#undef PG8_WAIT_V
#undef PG8_WAIT_L
#undef PG8_BAR
#undef PG8_SCHED
}
}

namespace att {
constexpr int D = 128, NW = 8, QBLK = 32, KVBLK = 64;
constexpr float THR = 8.f;
#ifndef ATT_SDEPTH
#define ATT_SDEPTH 1
#endif
constexpr size_t SHM_V = KVBLK * D * 2, SHM_K = KVBLK * D * 2, SHM_ATTN = 2 * SHM_V + 2 * SHM_K + NW * 64 * 4;
#define KSWZ(row, colB) ((row) * 256 + ((colB) ^ (((row) & 7) << 4)))
#define SBAR() __builtin_amdgcn_sched_barrier(0)
__device__ __forceinline__ int crow(int r, int hi) { return (r & 3) + 8 * (r >> 2) + 4 * hi; }
__device__ __forceinline__ void partialSM(f32x16& p0, f32x16& p1, float& m_reg, float& mn, float& alpha, float C, float thr) {
  float pmax = p0[0]; for (int r = 1; r < 16; ++r) pmax = fmaxf(pmax, p0[r]); for (int r = 0; r < 16; ++r) pmax = fmaxf(pmax, p1[r]);
  { auto rr = __builtin_amdgcn_permlane32_swap(__float_as_uint(pmax), __float_as_uint(pmax), false, false);
    pmax = fmaxf(__uint_as_float(rr[0]), __uint_as_float(rr[1])); }
  if (__builtin_expect(__all(pmax - m_reg <= thr), 1)) { mn = m_reg; alpha = 1.f; }
  else { mn = fmaxf(m_reg, pmax); alpha = __builtin_amdgcn_exp2f((m_reg - mn) * C); m_reg = mn; }
  float mnC = -mn * C;
  for (int r = 0; r < 16; ++r) p0[r] = fmaf(p0[r], C, mnC); for (int r = 0; r < 16; ++r) p1[r] = fmaf(p1[r], C, mnC);
  for (int r = 0; r < 16; ++r) p0[r] = __builtin_amdgcn_exp2f(p0[r]);
}
__device__ __forceinline__ void finishSM(f32x16& p0, f32x16& p1, float alpha, float& l_reg, bf16x8& pa0, bf16x8& pa1, bf16x8& pa2, bf16x8& pa3) {
  for (int r = 0; r < 16; ++r) p1[r] = __builtin_amdgcn_exp2f(p1[r]);
  float ps = 0; for (int r = 0; r < 16; ++r) ps += p0[r]; for (int r = 0; r < 16; ++r) ps += p1[r];
  { auto rr = __builtin_amdgcn_permlane32_swap(__float_as_uint(ps), __float_as_uint(ps), false, false);
    ps = __uint_as_float(rr[0]) + __uint_as_float(rr[1]); }
  l_reg = l_reg * alpha + ps;
#define PK4(P, BASE, OUT) do { unsigned a0 = cvt_pk_bf16(P[BASE + 0], P[BASE + 1]), a1 = cvt_pk_bf16(P[BASE + 2], P[BASE + 3]);   \
    unsigned b0 = cvt_pk_bf16(P[BASE + 4], P[BASE + 5]), b1 = cvt_pk_bf16(P[BASE + 6], P[BASE + 7]);                              \
    auto r0 = __builtin_amdgcn_permlane32_swap(a0, b0, false, false); auto r1 = __builtin_amdgcn_permlane32_swap(a1, b1, false, false); \
    u32x4 w = {r0[0], r1[0], r0[1], r1[1]}; OUT = *reinterpret_cast<bf16x8*>(&w); } while (0)
  PK4(p0, 0, pa0); PK4(p0, 8, pa1); PK4(p1, 0, pa2); PK4(p1, 8, pa3);
#undef PK4
}
#define QKT_STEP(d0) do { const int cb = ((d0) * 16 + hi * 8) * 2; \
    const bf16x8 b0 = *reinterpret_cast<const bf16x8*>((const char*)Ks + KSWZ(r32, cb)); \
    const bf16x8 b1 = *reinterpret_cast<const bf16x8*>((const char*)Ks + KSWZ(32 + r32, cb)); \
    p0 = __builtin_amdgcn_mfma_f32_32x32x16_bf16(b0, qr[d0], p0, 0, 0, 0); \
    p1 = __builtin_amdgcn_mfma_f32_32x32x16_bf16(b1, qr[d0], p1, 0, 0, 0); } while (0)
template <int qh> __device__ __forceinline__ void qkt(f32x16& p0, f32x16& p1, const bf16_t* Ks, const bf16x8* qr, int r32, int hi) {
  p0 = f32x16{}; p1 = f32x16{};
  if constexpr (qh != 2) { QKT_STEP(0); QKT_STEP(1); QKT_STEP(2); QKT_STEP(3); }
  if constexpr (qh != 1) { QKT_STEP(4); QKT_STEP(5); QKT_STEP(6); QKT_STEP(7); }
}
__device__ __forceinline__ int v_st(int k, int c) { const int kk = (k & ~0xC) | ((k & 4) << 1) | ((k & 8) >> 1); return ((kk >> 3) * 4 + (c >> 5)) * 512 + ((kk & 7) * 32 + (c & 31)) * 2; }
__device__ __forceinline__ int v_rd_base(int lane) { return ((lane & 3) << 3) | (((lane >> 2) & 3) << 6) | (((lane >> 4) & 1) << 5) | (((lane >> 5) & 1) << 8); }
constexpr int v_rd_off(int d0, int ks, int half) { return d0 * 512 + ks * 4096 + half * 2048; }
template <int OFF> __device__ __forceinline__ s16x4 tr_read(int vb) {
  s16x4 r; asm volatile("ds_read_b64_tr_b16 %0, %1 offset:%2" : "=&v"(r) : "v"(vb), "i"(OFF) : "memory"); return r;
}
template <int D0> __device__ __forceinline__ void pv_one(f32x16& od, int vb, bf16x8 pa0, bf16x8 pa1, bf16x8 pa2, bf16x8 pa3) {
  const s16x4 l0 = tr_read<v_rd_off(D0, 0, 0)>(vb), h0 = tr_read<v_rd_off(D0, 0, 1)>(vb), l1 = tr_read<v_rd_off(D0, 1, 0)>(vb), h1 = tr_read<v_rd_off(D0, 1, 1)>(vb);
  const s16x4 l2 = tr_read<v_rd_off(D0, 2, 0)>(vb), h2 = tr_read<v_rd_off(D0, 2, 1)>(vb), l3 = tr_read<v_rd_off(D0, 3, 0)>(vb), h3 = tr_read<v_rd_off(D0, 3, 1)>(vb);
  asm volatile("s_waitcnt lgkmcnt(0)" ::: "memory"); SBAR();
#define PK(L, H) (bf16x8){L[0], L[1], L[2], L[3], H[0], H[1], H[2], H[3]}
  od = __builtin_amdgcn_mfma_f32_32x32x16_bf16(pa0, PK(l0, h0), od, 0, 0, 0);
  od = __builtin_amdgcn_mfma_f32_32x32x16_bf16(pa1, PK(l1, h1), od, 0, 0, 0);
  od = __builtin_amdgcn_mfma_f32_32x32x16_bf16(pa2, PK(l2, h2), od, 0, 0, 0);
  od = __builtin_amdgcn_mfma_f32_32x32x16_bf16(pa3, PK(l3, h3), od, 0, 0, 0);
#undef PK
}
__device__ __forceinline__ void pv_d0(f32x16* o, int vb, bf16x8 pa0, bf16x8 pa1, bf16x8 pa2, bf16x8 pa3) {
  pv_one<0>(o[0], vb, pa0, pa1, pa2, pa3); pv_one<1>(o[1], vb, pa0, pa1, pa2, pa3); pv_one<2>(o[2], vb, pa0, pa1, pa2, pa3); pv_one<3>(o[3], vb, pa0, pa1, pa2, pa3);
}
template <int QH> __device__ __forceinline__ void attn_dense_body(const bf16_t* __restrict__ Qb, const bf16_t* __restrict__ Kh, const bf16_t* __restrict__ Vh,
                                                bf16_t* __restrict__ Ob, int seq, float scale, char* lds, const int tid) {
  constexpr int LDQ = 2048, LDK = 1024, LDO = 1024, SLOT = 32768;
  const float C = scale * 1.4426950408889634f, thr = THR / scale;
  const int wid = __builtin_amdgcn_readfirstlane(tid >> 6), lane = tid & 63, r32 = lane & 31, hi = lane >> 5;
  LAS unsigned char* L3 = (LAS unsigned char*)lds;
  float* ws = (float*)(lds + 4 * SLOT) + wid * 64; float* li_l = ws; float* al_l = ws + 32;
  float m_reg = -1e30f, l_reg = 0; f32x16 o[4] = {}; bf16x8 qr[8];
  const bf16_t* Qw = Qb + (long)(wid * QBLK + r32) * LDQ + hi * 8;
#pragma unroll
  for (int d0 = 0; d0 < 8; ++d0) qr[d0] = *reinterpret_cast<const bf16x8*>(Qw + d0 * 16);
  unsigned ko[2], vo[2];
#pragma unroll
  for (int n = 0; n < 2; ++n) { const int d = (n * 8 + wid) * 1024 + lane * 16;
    { const int r = d >> 8, pos = (d & 255) >> 4, c = pos ^ (r & 7); ko[n] = (unsigned)(r * LDK + c * 8) * 2u; }
    { const int sb = d >> 9, e = d & 511, kk = (sb >> 2) * 8 + (e >> 6), k = (kk & ~0xC) | ((kk & 4) << 1) | ((kk & 8) >> 1), c = (sb & 3) * 32 + ((e & 63) >> 1); vo[n] = (unsigned)(k * LDK + c) * 2u; } }
  const int vrb = (int)(uintptr_t)lds + 16384 + v_rd_base(lane);
#define ADMA(t) do { const size_t tb_ = (size_t)(t) * (size_t)(KVBLK * LDK * 2); const unsigned so_ = (unsigned)((t) & 3) * SLOT + (unsigned)wid * 1024u; \
    _Pragma("unroll") for (int n_ = 0; n_ < 2; ++n_) { \
      __builtin_amdgcn_global_load_lds((const unsigned*)((const char*)Kh + tb_ + ko[n_]), (LAS unsigned*)(L3 + so_ + n_ * 8192), 16, 0, 0); \
      __builtin_amdgcn_global_load_lds((const unsigned*)((const char*)Vh + tb_ + vo[n_]), (LAS unsigned*)(L3 + so_ + 16384 + n_ * 8192), 16, 0, 0); } } while (0)
#define AWAIT(more) do { if (more) asm volatile("s_waitcnt vmcnt(4)" ::: "memory"); else asm volatile("s_waitcnt vmcnt(0)" ::: "memory"); } while (0)
#define ABAR() do { asm volatile("s_waitcnt lgkmcnt(0)" ::: "memory"); __builtin_amdgcn_s_barrier(); asm volatile("" ::: "memory"); } while (0)
#define KSLOT(t) ((const bf16_t*)(lds + ((t) & 3) * SLOT))
#define VSLOT(t) (vrb + ((t) & 3) * SLOT)
#define RESC(a) do { if (__any((a) < 1.f)) { if (hi == 0) al_l[r32] = (a); asm volatile("s_waitcnt lgkmcnt(0)" ::: "memory"); \
    for (int d = 0; d < 4; ++d) for (int r = 0; r < 16; ++r) o[d][r] *= al_l[crow(r, hi)]; } } while (0)
  f32x16 pA0, pA1, pB0, pB1; float mnA, mnB, alA, alB; bf16x8 pa0, pa1, pa2, pa3; const int NT = seq / KVBLK;
  ADMA(0); ADMA(1);
  asm volatile("s_waitcnt vmcnt(4)" ::: "memory"); ABAR();
  if (2 < NT) ADMA(2);
  qkt<QH>(pA0, pA1, KSLOT(0), qr, r32, hi); partialSM(pA0, pA1, m_reg, mnA, alA, C, thr);
  AWAIT(2 < NT); ABAR();
  for (int j = 1; j + 1 < NT; j += 2) {
    if (j + 2 < NT) ADMA(j + 2);
    SBAR(); qkt<QH>(pB0, pB1, KSLOT(j), qr, r32, hi);
    finishSM(pA0, pA1, alA, l_reg, pa0, pa1, pa2, pa3); SBAR();
    pv_d0(o, VSLOT(j - 1), pa0, pa1, pa2, pa3); partialSM(pB0, pB1, m_reg, mnB, alB, C, thr);
    AWAIT(j + 2 < NT); ABAR();
    RESC(alB);
    if (j + 3 < NT) ADMA(j + 3);
    SBAR(); qkt<QH>(pA0, pA1, KSLOT(j + 1), qr, r32, hi);
    finishSM(pB0, pB1, alB, l_reg, pa0, pa1, pa2, pa3); SBAR();
    pv_d0(o, VSLOT(j), pa0, pa1, pa2, pa3); partialSM(pA0, pA1, m_reg, mnA, alA, C, thr);
    AWAIT(j + 3 < NT); ABAR();
    RESC(alA);
  }
  SBAR(); qkt<QH>(pB0, pB1, KSLOT(NT - 1), qr, r32, hi);
  finishSM(pA0, pA1, alA, l_reg, pa0, pa1, pa2, pa3); SBAR();
  pv_d0(o, VSLOT(NT - 2), pa0, pa1, pa2, pa3); partialSM(pB0, pB1, m_reg, mnB, alB, C, thr);
  RESC(alB);
  finishSM(pB0, pB1, alB, l_reg, pa0, pa1, pa2, pa3); SBAR();
  pv_d0(o, VSLOT(NT - 1), pa0, pa1, pa2, pa3);
  if (hi == 0) li_l[r32] = l_reg; asm volatile("s_waitcnt lgkmcnt(0)" ::: "memory");
  float rli[16];
#pragma unroll
  for (int r = 0; r < 16; ++r) rli[r] = __builtin_amdgcn_rcpf(li_l[crow(r, hi)]);
  bf16_t* Ow = Ob + (long)(wid * QBLK) * LDO;
#pragma unroll
  for (int r = 0; r < 16; ++r) { int orow = crow(r, hi);
    for (int d0 = 0; d0 < 4; ++d0) Ow[(long)orow * LDO + d0 * 32 + r32] = f2bf(o[d0][r] * rli[r]); }
#undef ADMA
#undef AWAIT
#undef ABAR
#undef KSLOT
#undef VSLOT
#undef RESC
}
}

template <int DK, int DVS, bool RET>
__device__ __forceinline__ void gla_unit(unsigned char* lds, int b, int h, int dir, int slice,
                                         const bf16_t* __restrict__ Q, const bf16_t* __restrict__ Kp, const bf16_t* __restrict__ V, const float* __restrict__ LF,
                                         bf16_t* __restrict__ Od, float lg, int ldv, int vcol0, const int tid) {
    constexpr int LK = DK + 8, LS = 72, NPG = 512 / DK, PPT = 64 / NPG, VPT = DVS / 8;
    constexpr int NVT = DVS / 16, NKT = DK / 16, TPW = NVT * NKT / 8, WPV = 8 / NVT, NOT = DVS / 32;
    constexpr int LV = DVS + 8;
    unsigned aQD = (unsigned)(uintptr_t)(LAS unsigned char*)lds, aKD = aQD + 64 * LK * 2, aSTB = aKD + 64 * LK * 2, aVI = aSTB + DVS * LK * 2,
             aAT = aVI + 64 * LV * 2, aEL = aAT + 64 * LS * 2, aTOT = aEL + DK * 4;
    asm volatile("" : "+s"(aQD), "+s"(aVI), "+s"(aAT), "+s"(aEL), "+s"(aTOT), "+s"(aKD), "+s"(aSTB));
    LAS bf16_t* QD = (LAS bf16_t*)(uintptr_t)aQD; LAS bf16_t* VI = (LAS bf16_t*)(uintptr_t)aVI; LAS bf16_t* AT = (LAS bf16_t*)(uintptr_t)aAT;
    LAS float* EL = (LAS float*)(uintptr_t)aEL; LAS float* TOT = (LAS float*)(uintptr_t)aTOT;
    LAS bf16_t* KD = (LAS bf16_t*)(uintptr_t)aKD; LAS bf16_t* STB = (LAS bf16_t*)(uintptr_t)aSTB;
    static_assert(2 * 64 * LK * 2 + DVS * LK * 2 + 64 * LV * 2 + 64 * LS * 2 + DK * 4 + 2048 <= 159744, "GLA LDS map");
    const int wid = tid >> 6, lane = tid & 63, l16 = lane & 15, quad = lane >> 4;
    const int tr = wid >> 1, tv = wid / WPV, kt0 = (wid % WPV) * TPW;
    const int vtr = (int)aVI + (8 * quad + (l16 >> 2)) * (LV * 2) + 8 * (lane & 3);
    const int ktr = (int)aKD + (8 * quad + (l16 >> 2)) * (LK * 2) + 8 * (lane & 3);
#define TRR(dst, base, OFF) asm volatile("ds_read_b64_tr_b16 %0, %1 offset:%2" : "=&v"(dst) : "v"(base), "i"(OFF) : "memory")
#define TRFRAG(L, H) (bf16x8){L[0], L[1], L[2], L[3], H[0], H[1], H[2], H[3]}
    f32x4 st[TPW];
#pragma unroll
    for (int t = 0; t < TPW; ++t) st[t] = (f32x4){0.f, 0.f, 0.f, 0.f};
#define GLA_BAR() do { asm volatile("s_waitcnt lgkmcnt(0)" ::: "memory"); __builtin_amdgcn_s_barrier(); asm volatile("" ::: "memory"); } while (0)
    typedef short vvec_t __attribute__((ext_vector_type(VPT)));
    constexpr int NQV = RET ? 4 : 1, NLC = RET ? 1 : PPT;
    bf16x8 qv[NQV], kv[NQV]; float lc[NLC]; bf16_t qr[NLC]; vvec_t vraw;
    const int kx = tid % DK, pg = tid / DK;
    const GAS bf16_t* Qg = (const GAS bf16_t*)Q; const GAS bf16_t* Kg = (const GAS bf16_t*)Kp; const GAS float* LFg = (const GAS float*)LF; const GAS bf16_t* Vg = (const GAS bf16_t*)V;
#define GLA_LOAD(SX) do { const int sx_ = (SX); const int cx_ = dir ? (sx_ < 4 ? 3 - sx_ : 71 - sx_) : sx_; const long Rx_ = (long)b * TB + cx_ * 64; \
        if constexpr (RET) { _Pragma("unroll") for (int j = 0; j < 4; ++j) { const int it = tid + 512 * j, p = it & 63, k0 = (it >> 6) * 8; const long row = Rx_ + (dir ? 63 - p : p); \
                qv[j] = *(const GAS bf16x8*)(Qg + row * 1024 + h * DK + k0); kv[j] = *(const GAS bf16x8*)(Kg + row * 1024 + h * DK + k0); } } \
        else { _Pragma("unroll") for (int i = 0; i < PPT; ++i) { const int p = pg * PPT + i; const long row = Rx_ + (dir ? 63 - p : p); \
                lc[i] = LFg[row * 2048 + dir * 1024 + h * DK + kx]; qr[i] = Qg[row * 1024 + h * DK + kx]; } } \
        } while (0)
    GLA_LOAD(0);
    for (int step = 0; step < 68; ++step) {
        const int cidx = dir ? (step < 4 ? 3 - step : 71 - step) : step;
        const long R0 = (long)b * TB + cidx * 64;
        GLA_BAR();
        {
#pragma unroll
            for (int t = 0; t < TPW; ++t)
#pragma unroll
                for (int j = 0; j < 4; ++j) STB[(tv * 16 + quad * 4 + j) * LK + (kt0 + t) * 16 + l16] = f2bf(st[t][j]);
            { const int p = tid >> 3, vg = tid & 7; const long row = R0 + (dir ? 63 - p : p); vraw = *(const GAS vvec_t*)(Vg + row * ldv + vcol0 + vg * VPT); }
            float bl;
            if constexpr (RET) {
                static_assert(!RET || DK == 256, "retention prep: 64 x 256 = 2048 eight-wide items, four per thread");
                bl = 64.f * lg;
#pragma unroll
                for (int j = 0; j < 4; ++j) { const int it = tid + 512 * j, p = it & 63, k0 = (it >> 6) * 8; const float bb = (float)(p + 1) * lg;
                    const float eq = __expf(bb), ek = __expf(-bb); float a[8], c[8];
#pragma unroll
                    for (int e = 0; e < 8; ++e) { a[e] = bf2f((bf16_t)qv[j][e]) * eq; c[e] = bf2f((bf16_t)kv[j][e]) * ek; }
                    *(LAS u32x4*)(QD + p * LK + k0) = pack8(a); *(LAS u32x4*)(KD + p * LK + k0) = pack8(c); }
            } else {
                float c = 0.f;
#pragma unroll
                for (int i = 0; i < PPT; ++i) c += lc[i];
                TOT[pg * 128 + kx] = c;
                GLA_BAR();
                float off = 0.f; bl = 0.f;
#pragma unroll
                for (int g = 0; g < NPG; ++g) { const float t = TOT[g * 128 + kx]; if (g < pg) off += t; bl += t; }
                float bb = off;
#pragma unroll
                for (int i = 0; i < PPT; ++i) { const int p = pg * PPT + i;
                    const float qf = bf2f(qr[i]), kf = 1.f - __expf(lc[i]); bb += lc[i];
                    QD[p * LK + kx] = f2bf(qf * __expf(bb)); KD[p * LK + kx] = f2bf(kf * __expf(-bb)); }
            }
            if (pg == 0) EL[kx] = __expf(bl);
            { const int p = tid >> 3, vg = tid & 7; *(LAS vvec_t*)(VI + p * LV + vg * VPT) = vraw; }
        }
        if (step + 1 < 68) GLA_LOAD(step + 1);
        GLA_BAR();
        {
            const int tcs = (wid & 1) * 2;
            f32x4 a0 = {0.f, 0.f, 0.f, 0.f}, a1 = {0.f, 0.f, 0.f, 0.f};
#pragma unroll
            for (int kk = 0; kk < DK / 32; ++kk) {
                const bf16x8 af = *(const LAS bf16x8*)(QD + (tr * 16 + l16) * LK + kk * 32 + quad * 8);
                const bf16x8 b0 = *(const LAS bf16x8*)(KD + (tcs * 16 + l16) * LK + kk * 32 + quad * 8);
                const bf16x8 b1 = *(const LAS bf16x8*)(KD + ((tcs + 1) * 16 + l16) * LK + kk * 32 + quad * 8);
                a0 = __builtin_amdgcn_mfma_f32_16x16x32_bf16(af, b0, a0, 0, 0, 0);
                a1 = __builtin_amdgcn_mfma_f32_16x16x32_bf16(af, b1, a1, 0, 0, 0);
                asm volatile("" ::: "memory");
            }
#pragma unroll
            for (int j = 0; j < 4; ++j) { const int p = tr * 16 + quad * 4 + j, s0 = tcs * 16 + l16, s1 = s0 + 16;
                AT[p * LS + s0] = f2bf((s0 <= p) ? a0[j] : 0.f); AT[p * LS + s1] = f2bf((s1 <= p) ? a1[j] : 0.f); }
        }
        GLA_BAR();
#pragma unroll
        for (int t = 0; t < NOT; ++t) { const int tc = (wid & 1) * NOT + t; f32x4 acc = {0.f, 0.f, 0.f, 0.f};
#pragma unroll
            for (int kk = 0; kk < DK / 32; ++kk) {
                const bf16x8 af = *(const LAS bf16x8*)(QD + (tr * 16 + l16) * LK + kk * 32 + quad * 8);
                const bf16x8 bf = *(const LAS bf16x8*)(STB + (tc * 16 + l16) * LK + kk * 32 + quad * 8);
                acc = __builtin_amdgcn_mfma_f32_16x16x32_bf16(af, bf, acc, 0, 0, 0);
                if ((kk & 3) == 3) asm volatile("" ::: "memory"); }
            { s16x4 v00, v01, v10, v11; const int vb = vtr + tc * 32;
                TRR(v00, vb, 0); TRR(v01, vb, 4 * LV * 2); TRR(v10, vb, 32 * LV * 2); TRR(v11, vb, 36 * LV * 2);
                const bf16x8 a0 = *(const LAS bf16x8*)(AT + (tr * 16 + l16) * LS + quad * 8), a1 = *(const LAS bf16x8*)(AT + (tr * 16 + l16) * LS + 32 + quad * 8);
                asm volatile("s_waitcnt lgkmcnt(0)" ::: "memory"); __builtin_amdgcn_sched_barrier(0);
                acc = __builtin_amdgcn_mfma_f32_16x16x32_bf16(a0, TRFRAG(v00, v01), acc, 0, 0, 0);
                acc = __builtin_amdgcn_mfma_f32_16x16x32_bf16(a1, TRFRAG(v10, v11), acc, 0, 0, 0); }
#pragma unroll
            for (int j = 0; j < 4; ++j) { const int p = tr * 16 + quad * 4 + j; const long row = R0 + (dir ? 63 - p : p);
                ((GAS bf16_t*)Od)[row * ldv + vcol0 + tc * 16 + l16] = f2bf(acc[j]); }
        }
        { s16x4 a00, a01, a10, a11; const int vb = vtr + tv * 32;
            TRR(a00, vb, 0); TRR(a01, vb, 4 * LV * 2); TRR(a10, vb, 32 * LV * 2); TRR(a11, vb, 36 * LV * 2);
#pragma unroll
            for (int t0 = 0; t0 < TPW; t0 += 2) {
                s16x4 b[2][4];
#pragma unroll
                for (int u = 0; u < 2; ++u) { const int kb = ktr + (kt0 + t0 + u) * 32;
                    TRR(b[u][0], kb, 0); TRR(b[u][1], kb, 4 * LK * 2); TRR(b[u][2], kb, 32 * LK * 2); TRR(b[u][3], kb, 36 * LK * 2); }
                asm volatile("s_waitcnt lgkmcnt(0)" ::: "memory"); __builtin_amdgcn_sched_barrier(0);
#pragma unroll
                for (int u = 0; u < 2; ++u) { const int t = t0 + u;
                    st[t] = __builtin_amdgcn_mfma_f32_16x16x32_bf16(TRFRAG(a00, a01), TRFRAG(b[u][0], b[u][1]), st[t], 0, 0, 0);
                    st[t] = __builtin_amdgcn_mfma_f32_16x16x32_bf16(TRFRAG(a10, a11), TRFRAG(b[u][2], b[u][3]), st[t], 0, 0, 0); }
            }
#pragma unroll
            for (int t = 0; t < TPW; ++t) st[t] = st[t] * EL[(kt0 + t) * 16 + l16];
        }
    }
    __syncthreads();
#undef TRR
#undef TRFRAG
#undef GLA_BAR
#undef GLA_LOAD
}

constexpr int LDS_BYTES = 160000;
struct Params { const float* in[26]; float* out; unsigned char* ws; };

__device__ __forceinline__ void sincos_cw(float x, float& s, float& c) {
    const float n = rintf(x * 0.6366197723675814f);
    float r = fmaf(-n, 1.5703125f, x); r = fmaf(-n, 4.837512969970703125e-4f, r); r = fmaf(-n, 7.54978995489188216e-8f, r);
    const float z = r * r;
    const float sp = r + r * z * (-1.6666654611e-1f + z * (8.3321608736e-3f + z * (-1.9515295891e-4f)));
    const float cp = 1.f - 0.5f * z + z * z * (4.166664568298827e-2f + z * (-1.388731625493765e-3f + z * 2.443315711809948e-5f));
    const int q = ((int)n) & 3;
    s = (q == 0) ? sp : (q == 1) ? cp : (q == 2) ? -sp : -cp;
    c = (q == 0) ? cp : (q == 1) ? -sp : (q == 2) ? -cp : sp;
}

__device__ __forceinline__ int permrow(int pt, int n) {
    if (pt == 1) { return n < FF ? (n / 128) * 256 + (n % 128) : ((n - FF) / 128) * 256 + 128 + ((n - FF) % 128); }
    if (pt == 2) { if (n >= 2048) return n; const int tile = n >> 8, ut = (n >> 6) & 3, w = n & 63; return tile * 256 + ((w >> 4) & 1) * 128 + ut * 32 + (w >> 5) * 16 + (w & 15); }
    if (pt == 3) { if (n >= 2048) return n; const int tile = n >> 8, w = n & 255; return tile * 256 + ((w >> 6) & 1) * 128 + (w >> 7) * 64 + (w & 63); }
    return n;
}
__device__ __forceinline__ void transpose_item(const float* __restrict__ W, int K, int N, bf16_t* __restrict__ WT, int pt, float* scr, int item, int lane) {
    const int nblk = N / 32, kb = item / nblk, nb = item % nblk, k0 = 64 * kb, n0 = 32 * nb;
    f32x4 wv[8];
#pragma unroll
    for (int i = 0; i < 8; ++i) { const int kk = 8 * i + (lane >> 3); wv[i] = __builtin_nontemporal_load((const f32x4*)&W[(size_t)(k0 + kk) * N + n0 + (lane & 7) * 4]); }
#pragma unroll
    for (int i = 0; i < 8; ++i) { const int kk = 8 * i + (lane >> 3); float* d = scr + kk * 33 + (lane & 7) * 4; d[0] = wv[i][0]; d[1] = wv[i][1]; d[2] = wv[i][2]; d[3] = wv[i][3]; }
    asm volatile("s_waitcnt lgkmcnt(0)" ::: "memory");
    const int c = lane & 7;
#pragma unroll
    for (int j = 0; j < 4; ++j) { const int n = (lane >> 3) + 8 * j; const float* s = scr + (8 * c) * 33 + n;
        u32x4 o; o.x = cvt_pk_bf16(s[0 * 33], s[1 * 33]); o.y = cvt_pk_bf16(s[2 * 33], s[3 * 33]); o.z = cvt_pk_bf16(s[4 * 33], s[5 * 33]); o.w = cvt_pk_bf16(s[6 * 33], s[7 * 33]);
        *(u32x4*)(WT + (size_t)permrow(pt, n0 + n) * K + k0 + 8 * c) = o; }
    asm volatile("s_waitcnt lgkmcnt(0)" ::: "memory");
}

#define XB_XCNT(j)  (64 + 64 * (j))
#define XB_XSUB(j)  (64 * 17 + 64 * (j))
#define XB_XGEN(j)  (64 * 33 + 64 * (j))
#define XB_TOP      (64 * 49)
#define XB_TOPGEN   (64 * 50)
#define XB_WORDS    (64 * 51)
__device__ __forceinline__ unsigned xb_add(unsigned* p, unsigned v) { return __hip_atomic_fetch_add(p, v, __ATOMIC_RELAXED, __HIP_MEMORY_SCOPE_AGENT); }
__device__ __forceinline__ unsigned xb_xcc_id() { return (unsigned)__builtin_amdgcn_s_getreg((3 << 11) | 20) & 0xFu; }
__device__ __forceinline__ void grid_bar(unsigned* bar, volatile LAS unsigned* st, int tid) {
    asm volatile("s_waitcnt vmcnt(0) lgkmcnt(0)" ::: "memory");
    __syncthreads();
    if (tid == 0) {
        const unsigned x = xb_xcc_id();
        unsigned nloc = st[0], nx = st[1];
        if (nloc == 0u) {
            const unsigned Gt = gridDim.x;
            for (;;) { unsigned sum = 0u, cnt = 0u, mine = 0u;
#pragma unroll
                for (unsigned j = 0; j < 16; ++j) { const unsigned c = xb_add(&bar[XB_XCNT(j)], 0u); sum += c; cnt += (c > 0u) ? 1u : 0u; mine = (j == x) ? c : mine; }
                if (sum == Gt) { nloc = mine; nx = cnt; break; }
                __builtin_amdgcn_s_sleep(2); }
            st[0] = nloc; st[1] = nx;
        }
        const unsigned old = xb_add(&bar[XB_XSUB(x)], 1u), gen = old / nloc;
        if (old + 1u == (gen + 1u) * nloc) {
            __builtin_amdgcn_fence(__ATOMIC_RELEASE, "agent");
            asm volatile("s_waitcnt vmcnt(0)" ::: "memory");
            const unsigned og = xb_add(&bar[XB_TOP], 1u), tg = og / nx;
            if (og + 1u == (tg + 1u) * nx) xb_add(&bar[XB_TOPGEN], 1u);
            else while (xb_add(&bar[XB_TOPGEN], 0u) == tg) __builtin_amdgcn_s_sleep(2);
            __builtin_amdgcn_fence(__ATOMIC_ACQUIRE, "agent");
            xb_add(&bar[XB_XGEN(x)], 1u);
            asm volatile("s_waitcnt vmcnt(0)" ::: "memory");
        } else {
            while (xb_add(&bar[XB_XGEN(x)], 0u) == gen) __builtin_amdgcn_s_sleep(2);
            __builtin_amdgcn_fence(__ATOMIC_ACQUIRE, "agent");
            asm volatile("s_waitcnt vmcnt(0)" ::: "memory");
        }
    }
    __syncthreads();
}
__device__ __forceinline__ void norm_row(const f32x4 (&v)[4], const float* __restrict__ sh, const float* __restrict__ sc, bf16_t* __restrict__ orow, int lane) {
    float s = 0.f;
#pragma unroll
    for (int j = 0; j < 4; ++j) s += (v[j].x * v[j].x + v[j].y * v[j].y) + (v[j].z * v[j].z + v[j].w * v[j].w);
    const float rinv = rsqrtf(wave_sum(s) * (1.f / DM) + EPS);
    u32x2* o8 = (u32x2*)orow + lane;
#pragma unroll
    for (int j = 0; j < 4; ++j) { const f32x4 a = *((const f32x4*)sh + lane + 64 * j), b = *((const f32x4*)sc + lane + 64 * j);
        const f32x4 y = v[j] * rinv * (b + 1.f) + a; u32x2 w; w.x = cvt_pk_bf16(y.x, y.y); w.y = cvt_pk_bf16(y.z, y.w); o8[64 * j] = w; }
}

__global__ void __launch_bounds__(512) mk_fwd(Params P) {
    extern __shared__ __attribute__((aligned(16))) unsigned char lds[];
    cg::grid_group grid = cg::this_grid();
    const int G = gridDim.x;
    unsigned bar_target = 0;
#define GRID_SYNC() do { if (ph == 0) { grid.sync(); if (threadIdx.x == 0) (void)xb_add((unsigned*)(P.ws + WS_XB) + XB_XCNT(xb_xcc_id()), 1u); } else grid_bar((unsigned*)(P.ws + WS_XB), (volatile LAS unsigned*)((LAS unsigned char*)lds + LDS_BYTES - 16), threadIdx.x); } while (0)

    constexpr int NPH = 2 + 44 + 1;
    for (int ph = 0; ph < NPH; ++ph) {
        int tid = threadIdx.x; asm volatile("" : "+v"(tid));
        int bid = blockIdx.x; asm volatile("" : "+s"(bid));
        unsigned char* ws = P.ws; asm volatile("" : "+s"(ws));
        const int lane = tid & 63, wave = __builtin_amdgcn_readfirstlane(tid >> 6), gw = bid * 8 + wave, NGW = G * 8;
        float* const H = (float*)(ws + WS_H); bf16_t* const XN = (bf16_t*)(ws + WS_XN); float* const MOD = (float*)(ws + WS_MOD); float* const MODP = (float*)(ws + WS_MODP);
        float* const LBV = (float*)(ws + WS_LBV); float* const ROPE = (float*)(ws + WS_ROPE);
        unsigned char* const BIG = ws + WS_BIG;
        const int l = (ph - 2) / 11, step = ph < 2 ? -1 : (ph == NPH - 1 ? -2 : (ph - 2) % 11);
        if (ph == 0) {
            const f32x4* x4 = (const f32x4*)P.in[0]; const f32x4* c4 = (const f32x4*)P.in[2]; f32x4* h4 = (f32x4*)H;
            for (size_t i = (size_t)bid * 512 + tid; i < (size_t)M * 256; i += (size_t)G * 512) {
                const int row = (int)(i >> 8), c = (int)(i & 255), bi = row / TB, rr = row - bi * TB;
                h4[i] = rr < CTXL ? c4[((size_t)bi * CTXL + rr) * 256 + c] : x4[((size_t)bi * SEQ + (rr - CTXL)) * 256 + c];
            }
            for (int e = bid * 512 + tid; e < 64 * 112; e += G * 512) {
                int pos, j, nq; size_t off;
                if (e < 64 * 16) { nq = 16; pos = e / 16; j = e % 16; off = ROPE16 + (size_t)e * 2; }
                else if (e < 64 * 48) { const int q = e - 64 * 16; nq = 32; pos = q / 32; j = q % 32; off = ROPE32 + (size_t)q * 2; }
                else { const int q = e - 64 * 48; nq = 64; pos = q / 64; j = q % 64; off = ROPE64 + (size_t)q * 2; }
                const float inv = exp2f(-(float)j / (float)nq * 13.287712379549449f);
                float sn, cs; sincos_cw((float)pos * inv, sn, cs);
                ROPE[off] = cs; ROPE[off + 1] = sn;
            }
            if (bid == 0) for (int i = tid; i < XB_WORDS; i += 512) __hip_atomic_store((unsigned*)(ws + WS_XB) + i, 0u, __ATOMIC_RELAXED, __HIP_MEMORY_SCOPE_AGENT);
            if (tid < 4) ((volatile LAS unsigned*)((LAS unsigned char*)lds + LDS_BYTES - 16))[tid] = 0u;
            float* cond = (float*)lds; float* red = cond + 5 * 1024;
            for (int i = tid; i < 5120; i += 512) { const int r = i >> 10, k = i & 1023; const float x = r < 4 ? P.in[1][r * 1024 + k] : P.in[3][k]; cond[i] = siluf(x); }
            __syncthreads();
            for (int unit = bid; unit < 1152; unit += G) {
                const int ks = unit & 7, cgp = (unit >> 3) % 36, ll = unit / 288;
                const float* W = P.in[4] + (size_t)ll * DM * NMOD + cgp * 256 + lane * 4;
                const int kbase = ks * 128 + wave * 16;
                f32x4 a[5];
#pragma unroll
                for (int r = 0; r < 5; ++r) a[r] = (f32x4){0.f, 0.f, 0.f, 0.f};
#pragma unroll 4
                for (int kk = 0; kk < 16; ++kk) { const int k = kbase + kk; const f32x4 w = __builtin_nontemporal_load((const f32x4*)(W + (size_t)k * NMOD));
#pragma unroll
                    for (int r = 0; r < 5; ++r) a[r] += w * cond[r * 1024 + k]; }
#pragma unroll
                for (int r = 0; r < 5; ++r) *(f32x4*)(red + (wave * 5 + r) * 256 + lane * 4) = a[r];
                __syncthreads();
                for (int o = tid; o < 1280; o += 512) { const int r = o >> 8, cc = o & 255; float sum = 0.f;
#pragma unroll
                    for (int w = 0; w < 8; ++w) sum += red[(w * 5 + r) * 256 + cc];
                    MODP[(size_t)((ks * 4 + ll) * 5 + r) * NMOD + cgp * 256 + cc] = sum; }
                __syncthreads();
            }
        } else if (ph == 1) {
            for (int i = bid * 512 + tid; i < 4 * 5 * NMOD; i += G * 512) { const int ll = i / (5 * NMOD), n = i % NMOD; float sum = P.in[5][ll * NMOD + n];
#pragma unroll
                for (int ks = 0; ks < 8; ++ks) sum += MODP[(size_t)ks * (4 * 5 * NMOD) + i];
                MOD[i] = sum; }
            for (int c = bid * 512 + tid; c < 1024; c += G * 512) { const float* lb = P.in[19]; const float a0 = lb[c], a1 = lb[1024 + c], a2 = lb[2048 + c], a3 = lb[3072 + c];
                const float mx = fmaxf(fmaxf(a0, a1), fmaxf(a2, a3)); const float e0 = __expf(a0 - mx), e1 = __expf(a1 - mx), e2 = __expf(a2 - mx), e3 = __expf(a3 - mx);
                LBV[c] = (e1 + e2) / (e0 + e1 + e2 + e3); }
        } else if (step == -2) {
            for (int r = gw; r < NB * SEQ; r += NGW) { const int bi = r >> 12, t = r & 4095; const size_t row = (size_t)bi * TB + CTXL + t;
                const f32x4* xr = (const f32x4*)(H + row * DM) + lane; f32x4 v[4]; float s = 0.f;
#pragma unroll
                for (int j = 0; j < 4; ++j) { v[j] = xr[64 * j]; s += (v[j].x * v[j].x + v[j].y * v[j].y) + (v[j].z * v[j].z + v[j].w * v[j].w); }
                const float rinv = rsqrtf(wave_sum(s) * (1.f / DM) + EPS);
                f32x4* op = (f32x4*)(P.out + (size_t)r * DM) + lane; const f32x4* gp = (const f32x4*)P.in[25] + lane;
#pragma unroll
                for (int j = 0; j < 4; ++j) op[64 * j] = v[j] * rinv * gp[64 * j]; }
        } else if (step == 0 || step == 3 || step == 8) {
            const float* modn = MOD + (size_t)l * 5 * NMOD + step * DM - (step == 8 ? 2 * DM : 0);
            const int ns = step == 0 ? (l == 0 ? 0 : 11) : step == 3 ? 11 : (l == 3 ? 0 : l == 1 ? 8 : 4);
            const float* PART = (const float*)(BIG + 3 * U1);
            for (int row = gw; row < M; row += NGW) {
                const int bi = row / TB, rr = row - bi * TB, mrow = rr < CTXL ? 4 : bi;
                const float* sh = modn + (size_t)mrow * NMOD;
                f32x4* hr = (f32x4*)(H + (size_t)row * DM) + lane; f32x4 v[4];
#pragma unroll
                for (int j = 0; j < 4; ++j) v[j] = hr[64 * j];
                if (ns && rr < CTXL) {
                    for (int sp = 0; sp < ns; ++sp) { const f32x4* pr = (const f32x4*)(PART + ((size_t)sp * 1024 + bi * 256 + rr) * DM) + lane;
#pragma unroll
                        for (int j = 0; j < 4; ++j) v[j] += pr[64 * j]; }
#pragma unroll
                    for (int j = 0; j < 4; ++j) hr[64 * j] = v[j];
                }
                norm_row(v, sh, sh + DM, XN + (size_t)row * DM, lane);
            }
            if (step == 0) {
                float* scr = (float*)lds + wave * (64 * 33);
                const float* win; const float* wout; int nin, kout, ptin;
                if (l == 0) { win = P.in[10]; wout = P.in[11]; nin = 3072; kout = 1024; ptin = 2; }
                else if (l == 1) { win = P.in[14]; wout = P.in[15]; nin = 6144; kout = 2048; ptin = 3; }
                else if (l == 2) { win = P.in[17]; wout = P.in[18]; nin = 5120; kout = 1024; ptin = 0; }
                else { win = P.in[21]; wout = P.in[22]; nin = 1536; kout = 1024; ptin = 0; }
                const int I13 = (DM / 64) * (2 * FF / 32), I2 = (FF / 64) * (DM / 32), IIN = (DM / 64) * (nin / 32), IOUT = (kout / 64) * (DM / 32);
                const int NIT = 2 * I13 + 2 * I2 + IIN + IOUT;
                for (int it = gw; it < NIT; it += NGW) {
                    int r = it; const float* W; int K, N, pt; bf16_t* WT;
                    if (r < 2 * I13) { const int sel = r >= I13; r -= sel * I13; W = P.in[sel ? 8 : 6] + (size_t)l * DM * 2 * FF; K = DM; N = 2 * FF; pt = 1; WT = (bf16_t*)(ws + (sel ? WS_W13B : WS_W13A)); }
                    else if ((r -= 2 * I13) < 2 * I2) { const int sel = r >= I2; r -= sel * I2; W = P.in[sel ? 9 : 7] + (size_t)l * FF * DM; K = FF; N = DM; pt = 0; WT = (bf16_t*)(ws + (sel ? WS_W2B : WS_W2A)); }
                    else if ((r -= 2 * I2) < IIN) { W = win; K = DM; N = nin; pt = ptin; WT = (bf16_t*)(ws + WS_WIN); }
                    else { r -= IIN; W = wout; K = kout; N = DM; pt = 0; WT = (bf16_t*)(ws + WS_WOUT); }
                    transpose_item(W, K, N, WT, pt, scr, r, lane);
                }
            }
        } else if (step == 1 || step == 2 || step == 4 || step == 7 || step == 9 || step == 10) {
            pg8::EpiAll E{}; pg8::Gemm g{}; int nN, lat = 0, resid = 0; E.ws = ws;
            if (step == 1 || step == 9) { E.kind = pg8::K_SWIGLU; g.A = XN; g.Bt = (const bf16_t*)(ws + (step == 1 ? WS_W13A : WS_W13B)); g.K = DM; nN = 22; lat = (step == 9 && l == 3); }
            else if (step == 2 || step == 10) { E.kind = pg8::K_RESID; E.aux = l * 16 + (step == 2 ? 2 : 8); g.A = (const bf16_t*)BIG; g.Bt = (const bf16_t*)(ws + (step == 2 ? WS_W2A : WS_W2B)); g.K = FF; nN = 4; lat = 1; resid = (step == 10 && l == 3) ? 1 : 2; }
            else if (step == 7) { E.kind = pg8::K_RESID; E.aux = l * 16 + 5; g.Bt = (const bf16_t*)(ws + WS_WOUT); nN = 4; lat = 1; resid = (l == 3) ? 1 : 2;
                g.A = (const bf16_t*)(BIG + (l == 0 ? 6 * U1 : l == 1 ? 4 * U1 : l == 2 ? 9 * U1 : 7 * U1)); g.K = (l == 1) ? 2048 : DM; }
            else { g.A = XN; g.Bt = (const bf16_t*)(ws + WS_WIN); g.K = DM;
                if (l == 0) { E.kind = pg8::K_DIFF; nN = 12; } else if (l == 1) { E.kind = pg8::K_RET; nN = 24; } else if (l == 2) { E.kind = pg8::K_HGRN; nN = 20; } else { E.kind = pg8::K_GQA; nN = 6; } }
            const int npass = resid == 2 ? 2 : 1;
            for (int pass = 0; pass < npass; ++pass) {
                pg8::Order S; g.nt = pass ? 4 : g.K / 64; if (pass) E.kind = pg8::K_PART;
                S.init(lat ? 64 : 68, nN, G, bid, pass ? 2 : lat, g.K / 256);
                pg8::gemm_phase<pg8::EpiAll, pg8::Order>((LAS unsigned char*)lds, g, S, E, tid);
            }
        } else if ((step == 5 && l == 0) || (step == 6 && l == 3)) {
            const bool df = (l == 0);
            const bf16_t* Qp = (const bf16_t*)(BIG + (df ? 0 : 3 * U1)); const bf16_t* Kp = (const bf16_t*)(BIG + (df ? 2 * U1 : 5 * U1)); const bf16_t* Vp = (const bf16_t*)(BIG + (df ? 3 * U1 : 6 * U1));
            bf16_t* Op = (bf16_t*)(BIG + (df ? 4 * U1 : 7 * U1));
            const int nun = df ? 1088 : 512; const float scale = df ? 1.0f : 0.08838834764831845f;
            for (int L = bid; L < nun; L += G) {
                int bq, hm, qb, seq, kvh;
                if (df) { if (L < 1024) { qb = (L & 15) + 1; hm = (L >> 4) & 15; bq = L >> 8; seq = TB; } else { const int L2 = L - 1024; hm = L2 & 15; bq = L2 >> 4; qb = 0; seq = CTXL; } kvh = hm >> 1; }
                else { qb = (L & 15) + 1; hm = (L >> 4) & 7; bq = L >> 7; seq = TB; kvh = hm >> 2; }
                const size_t r0 = (size_t)bq * TB + qb * 256;
                const size_t qoff = r0 * 2048 + hm * 128, koff = (size_t)bq * TB * 1024 + kvh * 128, ooff = (size_t)(hm >> 3) * ((size_t)M * 1024) + r0 * 1024 + (hm & 7) * 128;
                if (!df) att::attn_dense_body<0>(Qp + qoff, Kp + koff, Vp + koff, Op + ooff, seq, scale, (char*)lds, tid);
                else if (hm & 1) att::attn_dense_body<2>(Qp + qoff, Kp + koff, Vp + koff, Op + ooff, seq, scale, (char*)lds, tid);
                else att::attn_dense_body<1>(Qp + qoff, Kp + koff, Vp + koff, Op + ooff, seq, scale, (char*)lds, tid);
                __syncthreads();
            }
        } else if (step == 6 && l == 0) {
            const bf16_t* Ob = (const bf16_t*)(BIG + 4 * U1); bf16_t* A2b = (bf16_t*)(BIG + 6 * U1);
            const float* lam = P.in[12]; const float la = lam[lane] * lam[64 + lane], lb2 = lam[128 + lane] * lam[192 + lane];
            const float lam_full = __expf(wave_sum(la)) - __expf(wave_sum(lb2)) + 0.2f;
            const int hh = lane >> 3, v0 = (lane & 7) * 16;
            for (int row = gw; row < M; row += NGW) {
                const bf16_t* p0 = Ob + (size_t)(hh >> 2) * ((size_t)M * 1024) + (size_t)row * 1024 + ((2 * hh) & 7) * 128 + v0; const bf16_t* p1 = p0 + 128;
                const bf16x8 a0 = *(const bf16x8*)p0, a1 = *(const bf16x8*)(p0 + 8), b0 = *(const bf16x8*)p1, b1 = *(const bf16x8*)(p1 + 8);
                float o[16]; float s = 0.f;
#pragma unroll
                for (int e = 0; e < 8; ++e) { o[e] = bf2f((bf16_t)a0[e]) - lam_full * bf2f((bf16_t)b0[e]); o[8 + e] = bf2f((bf16_t)a1[e]) - lam_full * bf2f((bf16_t)b1[e]); }
#pragma unroll
                for (int e = 0; e < 16; ++e) s += o[e] * o[e];
                s += __shfl_xor(s, 1); s += __shfl_xor(s, 2); s += __shfl_xor(s, 4);
                const float rinv = rsqrtf(s * (1.f / 128.f) + EPS) * 0.8f;
#pragma unroll
                for (int e = 0; e < 16; ++e) o[e] = o[e] * rinv * P.in[13][v0 + e];
                bf16_t* dp = A2b + (size_t)row * 1024 + hh * 128 + v0;
                *(u32x4*)dp = pack8(o); *(u32x4*)(dp + 8) = pack8(o + 8);
            }
        } else if (step == 5 && l == 1) {
            const bf16_t* Qb = (const bf16_t*)BIG; const bf16_t* Kb = (const bf16_t*)(BIG + U1); const bf16_t* Vb = (const bf16_t*)(BIG + 2 * U1); bf16_t* OF = (bf16_t*)(BIG + 6 * U1); bf16_t* OB = (bf16_t*)(BIG + 8 * U1);
            for (int L = bid; L < 256; L += G) {
                const int slice = L & 7, dir = (L >> 3) & 1, hh = (L >> 4) & 3, bq = L >> 6;
                const float lg = __logf(1.f - exp2f(-P.in[16][dir * 4 + hh]));
                gla_unit<256, 64, true>(lds, bq, hh, dir, slice, Qb, Kb, Vb, nullptr, dir ? OB : OF, lg, 2048, hh * 512 + slice * 64, tid);
            }
        } else if (step == 6 && l == 1) {
            bf16_t* Gb = (bf16_t*)(BIG + 4 * U1); const bf16_t* OF = (const bf16_t*)(BIG + 6 * U1); const bf16_t* OB = (const bf16_t*)(BIG + 8 * U1);
            for (int row = gw; row < M; row += NGW) {
#pragma unroll
                for (int hh = 0; hh < 4; ++hh) { const size_t off = (size_t)row * 2048 + hh * 512 + lane * 8;
                    const bf16x8 a = *(const bf16x8*)(OF + off), b = *(const bf16x8*)(OB + off), gt = *(const bf16x8*)(Gb + off);
                    float o[8]; float s = 0.f;
#pragma unroll
                    for (int e = 0; e < 8; ++e) { o[e] = bf2f((bf16_t)a[e]) + bf2f((bf16_t)b[e]); s += o[e] * o[e]; }
                    const float rinv = rsqrtf(wave_sum(s) * (1.f / 512.f) + EPS);
#pragma unroll
                    for (int e = 0; e < 8; ++e) o[e] = o[e] * rinv * bf2f((bf16_t)gt[e]);
                    *(u32x4*)(Gb + off) = pack8(o); }
            }
        } else if (step == 5 && l == 2) {
            const bf16_t* Qb = (const bf16_t*)BIG; const bf16_t* Vb = (const bf16_t*)(BIG + U1); const float* LF = (const float*)(BIG + 3 * U1); bf16_t* OF = (bf16_t*)(BIG + 7 * U1); bf16_t* OB = (bf16_t*)(BIG + 8 * U1);
            for (int L = bid; L < 256; L += G) {
                const int slice = L & 3, dir = (L >> 2) & 1, hh = (L >> 3) & 7, bq = L >> 6;
                gla_unit<128, 32, false>(lds, bq, hh, dir, slice, Qb, nullptr, Vb, LF, dir ? OB : OF, 0.f, 1024, hh * 128 + slice * 32, tid);
            }
        } else if (step == 6 && l == 2) {
            const bf16_t* Gb = (const bf16_t*)(BIG + 2 * U1); const bf16_t* OF = (const bf16_t*)(BIG + 7 * U1); const bf16_t* OB = (const bf16_t*)(BIG + 8 * U1); bf16_t* A2b = (bf16_t*)(BIG + 9 * U1);
            const int v0 = (lane & 7) * 16;
            for (int row = gw; row < M; row += NGW) { const size_t off = (size_t)row * 1024 + lane * 16;
                const bf16x8 a0 = *(const bf16x8*)(OF + off), a1 = *(const bf16x8*)(OF + off + 8), b0 = *(const bf16x8*)(OB + off), b1 = *(const bf16x8*)(OB + off + 8);
                const bf16x8 g0 = *(const bf16x8*)(Gb + off), g1 = *(const bf16x8*)(Gb + off + 8);
                float o[16]; float s = 0.f;
#pragma unroll
                for (int e = 0; e < 8; ++e) { o[e] = bf2f((bf16_t)a0[e]) + bf2f((bf16_t)b0[e]); o[8 + e] = bf2f((bf16_t)a1[e]) + bf2f((bf16_t)b1[e]); }
#pragma unroll
                for (int e = 0; e < 16; ++e) s += o[e] * o[e];
                s += __shfl_xor(s, 1); s += __shfl_xor(s, 2); s += __shfl_xor(s, 4);
                const float rinv = rsqrtf(s * (1.f / 128.f) + EPS);
#pragma unroll
                for (int e = 0; e < 8; ++e) { o[e] = o[e] * rinv * P.in[20][v0 + e] * bf2f((bf16_t)g0[e]); o[8 + e] = o[8 + e] * rinv * P.in[20][v0 + 8 + e] * bf2f((bf16_t)g1[e]); }
                *(u32x4*)(A2b + off) = pack8(o); *(u32x4*)(A2b + off + 8) = pack8(o + 8); }
        } else if (step == 5 && l == 3) {
            const float* QKR = (const float*)BIG; bf16_t* Qb = (bf16_t*)(BIG + 3 * U1); bf16_t* Kb = (bf16_t*)(BIG + 5 * U1);
            const float* tab = ROPE + ROPE32; const int jj = lane & 31;
            const float gq0 = P.in[23][lane], gq1 = P.in[23][lane + 64], gk0 = P.in[24][lane], gk1 = P.in[24][lane + 64];
            for (int it = gw; it < M * 10; it += NGW) { const int row = it / 10, slot = it - row * 10; const int bi = row / TB, rr = row - bi * TB;
                const float* src = QKR + (size_t)row * 1280 + slot * 128;
                float x0 = src[lane], x1 = src[lane + 64];
                const float rinv = rsqrtf(wave_sum(x0 * x0 + x1 * x1) * (1.f / 128.f) + EPS);
                x0 = x0 * rinv * (slot < 8 ? gq0 : gk0); x1 = x1 * rinv * (slot < 8 ? gq1 : gk1);
                if (rr >= CTXL) { const int t = rr - CTXL, pr = t >> 6, pc = t & 63;
                    const float c0 = tab[(pr * 32 + jj) * 2], s0 = tab[(pr * 32 + jj) * 2 + 1], c1 = tab[(pc * 32 + jj) * 2], s1 = tab[(pc * 32 + jj) * 2 + 1];
                    const float y0 = __shfl_xor(x0, 32), y1 = __shfl_xor(x1, 32);
                    x0 = lane < 32 ? x0 * c0 - y0 * s0 : x0 * c0 + y0 * s0;
                    x1 = lane < 32 ? x1 * c1 - y1 * s1 : x1 * c1 + y1 * s1; }
                bf16_t* dst = slot < 8 ? Qb + (size_t)row * 2048 + slot * 128 : Kb + (size_t)row * 1024 + (slot - 8) * 128;
                dst[lane] = f2bf(x0); dst[lane + 64] = f2bf(x1); }
        }
        if (ph + 1 < NPH) GRID_SYNC();
    }
}

extern "C" void kernel_launch(void* const* d_in, const int* in_sizes, int n_in, void* d_out, int out_size, void* d_ws, size_t ws_size, hipStream_t stream) {
    static int grid = 0;
    if (grid == 0) {
        if (n_in != 26 || out_size != NB * SEQ * DM || ws_size < WS_END) { fprintf(stderr, "kernel_launch: unexpected shapes (n_in %d out %d ws %zu need %zu)\n", n_in, out_size, ws_size, (size_t)WS_END); grid = -1; return; }
        int dev = 0, cus = 0, per_cu = 0;
        if (hipGetDevice(&dev) != hipSuccess || hipDeviceGetAttribute(&cus, hipDeviceAttributeMultiprocessorCount, dev) != hipSuccess) { grid = -1; return; }
        if (hipFuncSetAttribute((const void*)mk_fwd, hipFuncAttributeMaxDynamicSharedMemorySize, LDS_BYTES) != hipSuccess) { fprintf(stderr, "kernel_launch: hipFuncSetAttribute failed\n"); grid = -1; return; }
        if (hipOccupancyMaxActiveBlocksPerMultiprocessor(&per_cu, (const void*)mk_fwd, 512, LDS_BYTES) != hipSuccess || per_cu < 1) { fprintf(stderr, "kernel_launch: occupancy query says %d\n", per_cu); per_cu = 1; }
        (void)hipGetLastError();
        grid = cus;
    }
    if (grid < 0) return;
    Params p{};
    for (int i = 0; i < 26; ++i) p.in[i] = (const float*)d_in[i];
    p.out = (float*)d_out; p.ws = (unsigned char*)d_ws;
    void* args[] = {&p};
    hipError_t e = hipLaunchCooperativeKernel((const void*)mk_fwd, dim3(grid), dim3(512), args, LDS_BYTES, stream);
    if (e != hipSuccess) fprintf(stderr, "cooperative launch failed: %s (grid %d)\n", hipGetErrorString(e), grid);
}
```

```cpp
#include <hip/hip_runtime.h>
#include <hip/hip_cooperative_groups.h>
#include <cstdio>
#include <cstdint>
namespace cg = cooperative_groups;

#define LAS __attribute__((address_space(3)))
#define GAS __attribute__((address_space(1)))
typedef unsigned short bf16_t;
typedef short bf16x8 __attribute__((ext_vector_type(8)));
typedef short s16x4 __attribute__((ext_vector_type(4)));
typedef float f32x4 __attribute__((ext_vector_type(4)));
typedef float f32x2 __attribute__((ext_vector_type(2)));
typedef float f32x16 __attribute__((ext_vector_type(16)));
typedef unsigned u32x4 __attribute__((ext_vector_type(4)));
typedef unsigned u32x2 __attribute__((ext_vector_type(2)));

constexpr int NB = 4, SEQ = 4096, CTXL = 256, TB = SEQ + CTXL  , M = NB * TB  , DM = 1024, FF = 2816, NMOD = 9 * DM;
constexpr float EPS = 1e-6f;

constexpr size_t al256(size_t x) { return (x + 255) / 256 * 256; }
constexpr size_t WS_H = 0;
constexpr size_t WS_XN = WS_H + (size_t)M * DM * 4;
constexpr size_t WS_MOD = WS_XN + (size_t)M * DM * 2;
constexpr size_t WS_MODP = WS_MOD + al256((size_t)4 * 5 * NMOD * 4);
constexpr size_t WS_LBV = WS_MODP + al256((size_t)8 * 4 * 5 * NMOD * 4);
constexpr size_t WS_ROPE = WS_LBV + 4096;
constexpr size_t ROPE16 = 0, ROPE32 = 64 * 16 * 2, ROPE64 = ROPE32 + 64 * 32 * 2;
constexpr size_t WS_BAR = WS_ROPE + 65536 - 256;
constexpr size_t WS_XB = WS_ROPE + 65536;
constexpr size_t WS_W13A = WS_XB + 16384;
constexpr size_t WS_W2A = WS_W13A + (size_t)2 * FF * DM * 2;
constexpr size_t WS_W13B = WS_W2A + (size_t)FF * DM * 2;
constexpr size_t WS_W2B = WS_W13B + (size_t)2 * FF * DM * 2;
constexpr size_t WS_WIN = WS_W2B + (size_t)FF * DM * 2;
constexpr size_t WS_WOUT = WS_WIN + (size_t)6144 * DM * 2;
constexpr size_t WS_BIG = WS_WOUT + (size_t)2048 * DM * 2;
constexpr size_t U1 = (size_t)M * DM * 2;
constexpr size_t WS_END = WS_BIG + 10 * U1;

typedef __bf16 bf16x2_t __attribute__((ext_vector_type(2)));
__device__ __forceinline__ unsigned cvt_pk_bf16(float lo, float hi) { const f32x2 v = {lo, hi}; const bf16x2_t b = __builtin_convertvector(v, bf16x2_t); return __builtin_bit_cast(unsigned, b); }
__device__ __forceinline__ bf16_t f2bf(float x) { return (bf16_t)(cvt_pk_bf16(x, x) & 0xffffu); }
__device__ __forceinline__ float bf2f(bf16_t v) { return __uint_as_float((unsigned)v << 16); }
__device__ __forceinline__ float siluf(float x) { return x * __builtin_amdgcn_rcpf(1.f + __expf(-x)); }
__device__ __forceinline__ float wave_sum(float v) {
#pragma unroll
    for (int o = 1; o < 64; o <<= 1) v += __shfl_xor(v, o);
    return v;
}
__device__ __forceinline__ u32x4 pack8(const float* v) { u32x4 w; w.x = cvt_pk_bf16(v[0], v[1]); w.y = cvt_pk_bf16(v[2], v[3]); w.z = cvt_pk_bf16(v[4], v[5]); w.w = cvt_pk_bf16(v[6], v[7]); return w; }

namespace pg8 {
constexpr int BM = 256, BK = 64, HALF = 128, HTB = HALF * BK * 2, STAGE_BYTES = 8 * HTB, NXCD = 8, WGM = 8;
__host__ __device__ __forceinline__ int lds_byte(int r, int c) { const int st = (r >> 4) * 2 + (c >> 5), rr = r & 15, cc = c & 31, ob = rr * 64 + cc * 2; return st * 1024 + (ob ^ (((ob >> 9) & 1) << 5)); }
__host__ __device__ __forceinline__ void stage_rc(int b, int& R, int& C) { const int st = b / 1024, sb = b % 1024, swz = sb ^ (((sb >> 9) & 1) << 5); R = (st >> 1) * 16 + swz / 64; C = (st & 1) * 32 + (swz % 64) / 2; }
__host__ __device__ __forceinline__ int perm32(int rho) { const int n = rho >> 4, i = rho & 15; return 8 * (i >> 2) + 4 * n + (i & 3); }
struct Unit { int pm, pn, kb; };
struct Gemm { const bf16_t* A; const bf16_t* Bt; int K, nt; };
struct Order {
    int nM, nN, nwg, G, c, mode, nsplit;
    __device__ void init(int nM_, int nN_, int G_, int c_, int mode_, int nsplit_) { nM = nM_; nN = nN_; nwg = mode_ == 2 ? 16 * nsplit_ : nM * nN; G = G_; c = c_; mode = mode_; nsplit = nsplit_; }
    __device__ bool next(int i, Unit& u) const {
        const long L = (long)i * G + c; if (L >= nwg) return false;
        if (mode == 2) { const int sp = (int)L % nsplit, t = (int)L / nsplit; u.pn = t & 3; u.pm = 17 * (t >> 2); u.kb = sp * 512; return true; }
        int wgid = (int)L; { const int q = nwg / NXCD, r = nwg % NXCD, xcd = wgid % NXCD, off = wgid / NXCD; wgid = (xcd < r ? xcd * (q + 1) : r * (q + 1) + (xcd - r) * q) + off; }
        const int nig = WGM * nN, gid = wgid / nig, fm = gid * WGM, gsz = (nM - fm) < WGM ? (nM - fm) : WGM;
        u.pm = fm + ((wgid % nig) % gsz); u.pn = (wgid % nig) / gsz; u.kb = 0;
        if (mode == 1) u.pm = u.pm + u.pm / 16 + 1;
        return true;
    }
};

enum { K_SWIGLU = 0, K_RESID = 1, K_DIFF = 2, K_RET = 3, K_HGRN = 4, K_GQA = 5, K_PART = 6 };
struct EpiAll {
    static constexpr bool PERM = true;
    int kind, aux;
    unsigned char* ws;
    __device__ __forceinline__ void plain(const f32x4 (&acc)[2][2][4][2], int row0, int wc, int fq, bf16_t* dst, int ld, int colbase, int act) const {
#pragma unroll
        for (int ai = 0; ai < 2; ++ai)
#pragma unroll
            for (int m = 0; m < 4; ++m) { bf16_t* rp = dst + (size_t)(row0 + ai * 128 + m * 16) * ld + colbase + wc * 32 + 8 * fq;
#pragma unroll
                for (int bj = 0; bj < 2; ++bj) { float v[8];
#pragma unroll
                    for (int e = 0; e < 8; ++e) { float x = acc[ai][bj][m][e >> 2][e & 3]; v[e] = act ? siluf(x) : x; }
                    *(u32x4*)(rp + bj * 128) = pack8(v); }
                asm volatile("" ::: "memory"); }
    }
    template <int NQ> __device__ __forceinline__ void roped(const float* rope, const f32x4 (&acc)[2][2][4][2], int row0, bool is_ctx, int rowb  , int axis, int j0,
                                                             bf16_t* dst, int ld, int c1, int dx2, float sc, int cz  ) const {
#pragma unroll
        for (int ai = 0; ai < 2; ++ai)
#pragma unroll
            for (int m = 0; m < 4; ++m) { const int row = row0 + ai * 128 + m * 16; float y1[8], y2[8];
                if (!is_ctx) { const int t = row - rowb, pos = axis ? (t & 63) : (t >> 6); const f32x4* tp = (const f32x4*)(rope + (size_t)(pos * NQ + j0) * 2);
#pragma unroll
                    for (int q = 0; q < 4; ++q) { const f32x4 cs = tp[q];
#pragma unroll
                        for (int hh = 0; hh < 2; ++hh) { const int e = 2 * q + hh; const float c = hh ? cs[2] : cs[0], s = hh ? cs[3] : cs[1];
                            const float x1 = acc[ai][0][m][e >> 2][e & 3], x2 = acc[ai][1][m][e >> 2][e & 3];
                            y1[e] = (x1 * c - x2 * s) * sc; y2[e] = (x2 * c + x1 * s) * sc; } }
                } else {
#pragma unroll
                    for (int e = 0; e < 8; ++e) { y1[e] = acc[ai][0][m][e >> 2][e & 3] * sc; y2[e] = acc[ai][1][m][e >> 2][e & 3] * sc; }
                }
                bf16_t* rp = dst + (size_t)row * ld;
                *(u32x4*)(rp + c1) = pack8(y1); *(u32x4*)(rp + c1 + dx2) = pack8(y2);
                if (cz >= 0) { const u32x4 z = {0u, 0u, 0u, 0u}; *(u32x4*)(rp + cz) = z; *(u32x4*)(rp + cz + dx2) = z; }
                asm volatile("" ::: "memory"); }
    }
    __device__ __forceinline__ void operator()(const f32x4 (&acc)[2][2][4][2], const Unit& u, int wr, int wc, int fr, int fq) const {
        asm volatile("" : "+v"(fr), "+v"(fq));
        const int row0 = u.pm * BM + wr * 64 + fr;
        const int batch = u.pm / 17; const bool is_ctx = (u.pm % 17) == 0; const int rowb = batch * TB + CTXL;
        unsigned char* const BIG = ws + WS_BIG;
        if (kind == K_SWIGLU) {
            bf16_t* o0 = (bf16_t*)BIG;
#pragma unroll
            for (int ai = 0; ai < 2; ++ai)
#pragma unroll
                for (int m = 0; m < 4; ++m) { float v[8];
#pragma unroll
                    for (int e = 0; e < 8; ++e) v[e] = siluf(acc[ai][0][m][e >> 2][e & 3]) * acc[ai][1][m][e >> 2][e & 3];
                    *(u32x4*)(o0 + (size_t)(row0 + ai * 128 + m * 16) * FF + u.pn * 128 + wc * 32 + 8 * fq) = pack8(v);
                    asm volatile("" ::: "memory"); }
        } else if (kind == K_RESID) {
            const int mrow = is_ctx ? 4 : batch; const int col0 = u.pn * BM + wc * 32 + 8 * fq; const int gidx = aux & 15, ll = aux >> 4;
            const float gs = gidx == 5 ? 1.f : 0.5f; float* f0 = (float*)(ws + WS_H);
            const float* g = (const float*)(ws + WS_MOD) + (size_t)(ll * 5 + mrow) * NMOD + gidx * DM + col0;
            f32x4 gv[2][2];
#pragma unroll
            for (int bj = 0; bj < 2; ++bj)
#pragma unroll
                for (int n = 0; n < 2; ++n) gv[bj][n] = *(const f32x4*)(g + bj * 128 + 4 * n) * gs;
#pragma unroll
            for (int ai = 0; ai < 2; ++ai)
#pragma unroll
                for (int m = 0; m < 4; ++m) { float* hp = f0 + (size_t)(row0 + ai * 128 + m * 16) * DM + col0;
#pragma unroll
                    for (int bj = 0; bj < 2; ++bj)
#pragma unroll
                        for (int n = 0; n < 2; ++n) { f32x4 h = *(f32x4*)(hp + bj * 128 + 4 * n); h += gv[bj][n] * acc[ai][bj][m][n]; *(f32x4*)(hp + bj * 128 + 4 * n) = h; }
                    asm volatile("" ::: "memory"); }
        } else if (kind == K_PART) {
            const int col0 = u.pn * BM + wc * 32 + 8 * fq; const int gidx = aux & 15, ll = aux >> 4; const float gs = gidx == 5 ? 1.f : 0.5f;
            const float* g = (const float*)(ws + WS_MOD) + (size_t)(ll * 5 + 4) * NMOD + gidx * DM + col0;
            float* part = (float*)(BIG + 3 * U1) + ((size_t)(u.kb >> 9) * 1024 + batch * 256 + (row0 - batch * TB)) * DM + col0;
            f32x4 gv[2][2];
#pragma unroll
            for (int bj = 0; bj < 2; ++bj)
#pragma unroll
                for (int n = 0; n < 2; ++n) gv[bj][n] = *(const f32x4*)(g + bj * 128 + 4 * n) * gs;
#pragma unroll
            for (int ai = 0; ai < 2; ++ai)
#pragma unroll
                for (int m = 0; m < 4; ++m) { float* pp = part + (size_t)(ai * 128 + m * 16) * DM;
#pragma unroll
                    for (int bj = 0; bj < 2; ++bj)
#pragma unroll
                        for (int n = 0; n < 2; ++n) *(f32x4*)(pp + bj * 128 + 4 * n) = gv[bj][n] * acc[ai][bj][m][n];
                    asm volatile("" ::: "memory"); }
        } else if (kind == K_DIFF) {
            const float* rope = (const float*)(ws + WS_ROPE) + ROPE16;
            if (u.pn < 8) { const int axis = fq >> 1, j0 = (fq & 1) * 8;
                if (u.pn < 4) { const int ug = u.pn * 4 + wc; roped<16>(rope, acc, row0, is_ctx, rowb, axis, j0, (bf16_t*)BIG, 2048, ug * 128 + (ug & 1) * 64 + axis * 32 + j0, 16, 0.125f, ug * 128 + ((ug & 1) ^ 1) * 64 + axis * 32 + j0); }
                else roped<16>(rope, acc, row0, is_ctx, rowb, axis, j0, (bf16_t*)(BIG + 2 * U1), 1024, (u.pn - 4) * 256 + wc * 64 + axis * 32 + j0, 16, 1.f, -1);
            } else plain(acc, row0, wc, fq, (bf16_t*)(BIG + 3 * U1), 1024, (u.pn - 8) * 256, 0);
        } else if (kind == K_RET) {
            const float* rope = (const float*)(ws + WS_ROPE) + ROPE64;
            if (u.pn < 8) { const int axis = wc >> 1, j0 = (wc & 1) * 32 + 8 * fq;
                if (u.pn < 4) roped<64>(rope, acc, row0, is_ctx, rowb, axis, j0, (bf16_t*)BIG, 1024, u.pn * 256 + axis * 128 + j0, 64, 1.f, -1);
                else roped<64>(rope, acc, row0, is_ctx, rowb, axis, j0, (bf16_t*)(BIG + U1), 1024, (u.pn - 4) * 256 + axis * 128 + j0, 64, 0.0625f, -1);
            } else if (u.pn < 16) plain(acc, row0, wc, fq, (bf16_t*)(BIG + 2 * U1), 2048, (u.pn - 8) * 256, 0);
            else plain(acc, row0, wc, fq, (bf16_t*)(BIG + 4 * U1), 2048, (u.pn - 16) * 256, 1);
        } else if (kind == K_HGRN) {
            if (u.pn < 4) plain(acc, row0, wc, fq, (bf16_t*)BIG, 1024, u.pn * 256, 1);
            else if (u.pn < 8) plain(acc, row0, wc, fq, (bf16_t*)(BIG + U1), 1024, (u.pn - 4) * 256, 0);
            else if (u.pn < 12) plain(acc, row0, wc, fq, (bf16_t*)(BIG + 2 * U1), 1024, (u.pn - 8) * 256, 1);
            else { const int cb = (u.pn - 12) * 256 + wc * 32 + 8 * fq; float* f0 = (float*)(BIG + 3 * U1); const float* lbv = (const float*)(ws + WS_LBV);
#pragma unroll
                for (int bj = 0; bj < 2; ++bj) { const int c = cb + bj * 128; f32x4 lb0 = *(const f32x4*)(lbv + (c & 1023)), lb1 = *(const f32x4*)(lbv + (c & 1023) + 4);
#pragma unroll
                    for (int ai = 0; ai < 2; ++ai)
#pragma unroll
                        for (int m = 0; m < 4; ++m) { float* rp = f0 + (size_t)(row0 + ai * 128 + m * 16) * 2048 + c; f32x4 r0, r1;
#pragma unroll
                            for (int i = 0; i < 4; ++i) { const float z0 = acc[ai][bj][m][0][i], z1 = acc[ai][bj][m][1][i];
                                const float s0 = __builtin_amdgcn_rcpf(1.f + __expf(-z0)), s1 = __builtin_amdgcn_rcpf(1.f + __expf(-z1));
                                r0[i] = __logf(lb0[i] + (1.f - lb0[i]) * s0); r1[i] = __logf(lb1[i] + (1.f - lb1[i]) * s1); }
                            *(f32x4*)rp = r0; *(f32x4*)(rp + 4) = r1; asm volatile("" ::: "memory"); } } }
        } else {
            if (u.pn < 5) { const int cb = u.pn * 256 + wc * 32 + 8 * fq; float* f0 = (float*)BIG;
#pragma unroll
                for (int ai = 0; ai < 2; ++ai)
#pragma unroll
                    for (int m = 0; m < 4; ++m) { float* rp = f0 + (size_t)(row0 + ai * 128 + m * 16) * 1280 + cb;
#pragma unroll
                        for (int bj = 0; bj < 2; ++bj) { *(f32x4*)(rp + bj * 128) = acc[ai][bj][m][0]; *(f32x4*)(rp + bj * 128 + 4) = acc[ai][bj][m][1]; } }
            } else plain(acc, row0, wc, fq, (bf16_t*)(BIG + 6 * U1), 1024, 0, 0);
        }
    }
};

template <class Epi, class Sched>
__device__ __forceinline__ void gemm_phase(LAS unsigned char* lds, const Gemm g, const Sched& S, const Epi& E, const int tid) {
    const int wid = __builtin_amdgcn_readfirstlane(tid >> 6), lane = tid & 63, wr = wid >> 2, wc = wid & 3, fr = lane & 15, fq = lane >> 4;
    const int K = g.K, nt = g.nt;
    unsigned voffA[2], voffB[2];
#pragma unroll
    for (int i = 0; i < 2; ++i) { int R, C; stage_rc(tid * 16 + i * 8192, R, C); const int Rb = Epi::PERM ? ((R & ~31) + perm32(R & 31)) : R;
        voffA[i] = (unsigned)(R * K + C) * 2u; voffB[i] = (unsigned)(Rb * K + C) * 2u; }
    const size_t kstep = (size_t)(BK * 2);
    const size_t hstep = (size_t)HALF * K * 2;
    const size_t tstep = 2 * hstep;
    const unsigned ldsw = (unsigned)wid * 1024u;
    const int aoff = lds_byte(wr * 64 + fr, fq * 8), boff = lds_byte(wc * 32 + fr, fq * 8);
#define PG8_SA(b, h) (((b) * 2 + (h)) * HTB)
#define PG8_SB(b, h) ((4 + (b) * 2 + (h)) * HTB)
#define PG8_STAGE(bufoff, gbase, voff) do { _Pragma("unroll") for (int _i = 0; _i < 2; ++_i) \
        __builtin_amdgcn_global_load_lds((const unsigned*)((const char*)(gbase) + (voff)[_i]), (LAS unsigned*)(lds + (bufoff) + ldsw + _i * 8192), 16, 0, 0); } while (0)
#define PG8_LDA(dst, b, h) do { _Pragma("unroll") for (int m = 0; m < 4; ++m) _Pragma("unroll") for (int k = 0; k < 2; ++k) dst[m][k] = *(const LAS bf16x8*)(lds + PG8_SA(b, h) + aoff + m * 2048 + k * 1024); } while (0)
#define PG8_LDB(dst, b, h) do { _Pragma("unroll") for (int n = 0; n < 2; ++n) _Pragma("unroll") for (int k = 0; k < 2; ++k) dst[n][k] = *(const LAS bf16x8*)(lds + PG8_SB(b, h) + boff + n * 2048 + k * 1024); } while (0)
#define PG8_MMA(ai, bj, At, Bt) do { __builtin_amdgcn_s_setprio(1); _Pragma("unroll") for (int m = 0; m < 4; ++m) _Pragma("unroll") for (int n = 0; n < 2; ++n) _Pragma("unroll") for (int k = 0; k < 2; ++k) \
        acc[ai][bj][m][n] = __builtin_amdgcn_mfma_f32_16x16x32_bf16(Bt[n][k], At[m][k], acc[ai][bj][m][n], 0, 0, 0); __builtin_amdgcn_s_setprio(0); } while (0)
#define PG8_WAIT_V(n) asm volatile("s_waitcnt vmcnt(" #n ")" ::: "memory")
#define PG8_WAIT_L(n) asm volatile("s_waitcnt lgkmcnt(" #n ")" ::: "memory")
#define PG8_BAR __builtin_amdgcn_s_barrier()
#define PG8_SCHED __builtin_amdgcn_sched_barrier(0)
    Unit cur, nxt; int ui = 0;
    if (!S.next(0, cur)) return;
    f32x4 acc[2][2][4][2];
#pragma unroll
    for (int a = 0; a < 2; ++a)
#pragma unroll
        for (int b = 0; b < 2; ++b)
#pragma unroll
            for (int m = 0; m < 4; ++m)
#pragma unroll
                for (int n = 0; n < 2; ++n) acc[a][b][m][n] = (f32x4){0.f, 0.f, 0.f, 0.f};
    bf16x8 At[4][2], B0[2][2], B1[2][2];
    const char* cA = (const char*)g.A + (size_t)cur.pm * tstep + cur.kb; const char* cB = (const char*)g.Bt + (size_t)cur.pn * tstep + cur.kb;
    PG8_STAGE(PG8_SB(0, 0), cB, voffB); PG8_STAGE(PG8_SB(0, 1), cB + hstep, voffB); PG8_STAGE(PG8_SA(0, 0), cA, voffA); PG8_STAGE(PG8_SA(0, 1), cA + hstep, voffA);
    if (wr == 1) PG8_BAR;
    PG8_WAIT_V(2); PG8_BAR;
    PG8_STAGE(PG8_SB(1, 0), cB + kstep, voffB); PG8_STAGE(PG8_SA(1, 0), cA + kstep, voffA); PG8_STAGE(PG8_SB(1, 1), cB + hstep + kstep, voffB);
    PG8_WAIT_V(6); PG8_BAR;
    for (;;) {
        const bool has_next = S.next(ui + 1, nxt);
        const char* nA = has_next ? (const char*)g.A + (size_t)nxt.pm * tstep + nxt.kb : cA; const char* nB = has_next ? (const char*)g.Bt + (size_t)nxt.pn * tstep + nxt.kb : cB;
        for (int t = 0; t < nt; t += 2) {
            const bool last = (t == nt - 2);
            const char* a1 = cA + (size_t)(t + 1) * kstep;
            const char* a2 = last ? nA : cA + (size_t)(t + 2) * kstep; const char* b2 = last ? nB : cB + (size_t)(t + 2) * kstep;
            const char* a3 = a2 + kstep; const char* b3 = b2 + kstep;
            PG8_LDB(B0, 0, 0); PG8_LDB(B1, 0, 1); PG8_SCHED; PG8_LDA(At, 0, 0); PG8_STAGE(PG8_SA(1, 1), a1 + hstep, voffA);
            PG8_WAIT_V(8); PG8_WAIT_L(0); PG8_BAR; PG8_MMA(0, 0, At, B0); PG8_MMA(0, 1, At, B1); PG8_BAR; PG8_SCHED;
            PG8_LDA(At, 0, 1); PG8_STAGE(PG8_SB(0, 0), b2, voffB); PG8_STAGE(PG8_SB(0, 1), b2 + hstep, voffB); PG8_STAGE(PG8_SA(0, 0), a2, voffA);
            PG8_WAIT_V(8); PG8_WAIT_L(0); PG8_BAR; PG8_MMA(1, 0, At, B0); PG8_MMA(1, 1, At, B1); PG8_BAR; PG8_SCHED;
            PG8_LDB(B0, 1, 0); PG8_LDB(B1, 1, 1); PG8_SCHED; PG8_LDA(At, 1, 0); PG8_STAGE(PG8_SA(0, 1), a2 + hstep, voffA);
            PG8_WAIT_V(8); PG8_WAIT_L(0); PG8_BAR; PG8_MMA(0, 0, At, B0); PG8_MMA(0, 1, At, B1); PG8_BAR; PG8_SCHED;
            PG8_LDA(At, 1, 1); PG8_STAGE(PG8_SB(1, 0), b3, voffB); PG8_STAGE(PG8_SB(1, 1), b3 + hstep, voffB); PG8_STAGE(PG8_SA(1, 0), a3, voffA);
            PG8_WAIT_V(8); PG8_WAIT_L(0); PG8_BAR; PG8_MMA(1, 0, At, B0); PG8_MMA(1, 1, At, B1); PG8_BAR; PG8_SCHED;
        }
        if (wr == 0) PG8_BAR;
        E(acc, cur, wr, wc, fr, fq);
        if (!has_next) break;
#pragma unroll
        for (int a = 0; a < 2; ++a)
#pragma unroll
            for (int b = 0; b < 2; ++b)
#pragma unroll
                for (int m = 0; m < 4; ++m)
#pragma unroll
                    for (int n = 0; n < 2; ++n) acc[a][b][m][n] = (f32x4){0.f, 0.f, 0.f, 0.f};
        cur = nxt; cA = nA; cB = nB; ++ui;
        if (wr == 1) PG8_BAR;
    }
    PG8_WAIT_V(0);
    PG8_BAR;
#undef PG8_SA
#undef PG8_SB
#undef PG8_STAGE
#undef PG8_LDA
#undef PG8_LDB
#undef PG8_MMA
#undef PG8_WAIT_V
#undef PG8_WAIT_L
#undef PG8_BAR
#undef PG8_SCHED
}
}

namespace att {
constexpr int D = 128, NW = 8, QBLK = 32, KVBLK = 64;
constexpr float THR = 8.f;
#ifndef ATT_SDEPTH
#define ATT_SDEPTH 1
#endif
constexpr size_t SHM_V = KVBLK * D * 2, SHM_K = KVBLK * D * 2, SHM_ATTN = 2 * SHM_V + 2 * SHM_K + NW * 64 * 4;
#define KSWZ(row, colB) ((row) * 256 + ((colB) ^ (((row) & 7) << 4)))
#define SBAR() __builtin_amdgcn_sched_barrier(0)
__device__ __forceinline__ int crow(int r, int hi) { return (r & 3) + 8 * (r >> 2) + 4 * hi; }
__device__ __forceinline__ void partialSM(f32x16& p0, f32x16& p1, float& m_reg, float& mn, float& alpha, float C, float thr) {
  float pmax = p0[0]; for (int r = 1; r < 16; ++r) pmax = fmaxf(pmax, p0[r]); for (int r = 0; r < 16; ++r) pmax = fmaxf(pmax, p1[r]);
  { auto rr = __builtin_amdgcn_permlane32_swap(__float_as_uint(pmax), __float_as_uint(pmax), false, false);
    pmax = fmaxf(__uint_as_float(rr[0]), __uint_as_float(rr[1])); }
  if (__builtin_expect(__all(pmax - m_reg <= thr), 1)) { mn = m_reg; alpha = 1.f; }
  else { mn = fmaxf(m_reg, pmax); alpha = __builtin_amdgcn_exp2f((m_reg - mn) * C); m_reg = mn; }
  float mnC = -mn * C;
  for (int r = 0; r < 16; ++r) p0[r] = fmaf(p0[r], C, mnC); for (int r = 0; r < 16; ++r) p1[r] = fmaf(p1[r], C, mnC);
  for (int r = 0; r < 16; ++r) p0[r] = __builtin_amdgcn_exp2f(p0[r]);
}
__device__ __forceinline__ void finishSM(f32x16& p0, f32x16& p1, float alpha, float& l_reg, bf16x8& pa0, bf16x8& pa1, bf16x8& pa2, bf16x8& pa3) {
  for (int r = 0; r < 16; ++r) p1[r] = __builtin_amdgcn_exp2f(p1[r]);
  float ps = 0; for (int r = 0; r < 16; ++r) ps += p0[r]; for (int r = 0; r < 16; ++r) ps += p1[r];
  { auto rr = __builtin_amdgcn_permlane32_swap(__float_as_uint(ps), __float_as_uint(ps), false, false);
    ps = __uint_as_float(rr[0]) + __uint_as_float(rr[1]); }
  l_reg = l_reg * alpha + ps;
#define PK4(P, BASE, OUT) do { unsigned a0 = cvt_pk_bf16(P[BASE + 0], P[BASE + 1]), a1 = cvt_pk_bf16(P[BASE + 2], P[BASE + 3]);   \
    unsigned b0 = cvt_pk_bf16(P[BASE + 4], P[BASE + 5]), b1 = cvt_pk_bf16(P[BASE + 6], P[BASE + 7]);                              \
    auto r0 = __builtin_amdgcn_permlane32_swap(a0, b0, false, false); auto r1 = __builtin_amdgcn_permlane32_swap(a1, b1, false, false); \
    u32x4 w = {r0[0], r1[0], r0[1], r1[1]}; OUT = *reinterpret_cast<bf16x8*>(&w); } while (0)
  PK4(p0, 0, pa0); PK4(p0, 8, pa1); PK4(p1, 0, pa2); PK4(p1, 8, pa3);
#undef PK4
}
#define QKT_STEP(d0) do { const int cb = ((d0) * 16 + hi * 8) * 2; \
    const bf16x8 b0 = *reinterpret_cast<const bf16x8*>((const char*)Ks + KSWZ(r32, cb)); \
    const bf16x8 b1 = *reinterpret_cast<const bf16x8*>((const char*)Ks + KSWZ(32 + r32, cb)); \
    p0 = __builtin_amdgcn_mfma_f32_32x32x16_bf16(b0, qr[d0], p0, 0, 0, 0); \
    p1 = __builtin_amdgcn_mfma_f32_32x32x16_bf16(b1, qr[d0], p1, 0, 0, 0); } while (0)
template <int qh> __device__ __forceinline__ void qkt(f32x16& p0, f32x16& p1, const bf16_t* Ks, const bf16x8* qr, int r32, int hi) {
  p0 = f32x16{}; p1 = f32x16{};
  if constexpr (qh != 2) { QKT_STEP(0); QKT_STEP(1); QKT_STEP(2); QKT_STEP(3); }
  if constexpr (qh != 1) { QKT_STEP(4); QKT_STEP(5); QKT_STEP(6); QKT_STEP(7); }
}
__device__ __forceinline__ int v_st(int k, int c) { const int kk = (k & ~0xC) | ((k & 4) << 1) | ((k & 8) >> 1); return ((kk >> 3) * 4 + (c >> 5)) * 512 + ((kk & 7) * 32 + (c & 31)) * 2; }
__device__ __forceinline__ int v_rd_base(int lane) { return ((lane & 3) << 3) | (((lane >> 2) & 3) << 6) | (((lane >> 4) & 1) << 5) | (((lane >> 5) & 1) << 8); }
constexpr int v_rd_off(int d0, int ks, int half) { return d0 * 512 + ks * 4096 + half * 2048; }
template <int OFF> __device__ __forceinline__ s16x4 tr_read(int vb) {
  s16x4 r; asm volatile("ds_read_b64_tr_b16 %0, %1 offset:%2" : "=&v"(r) : "v"(vb), "i"(OFF) : "memory"); return r;
}
template <int D0> __device__ __forceinline__ void pv_one(f32x16& od, int vb, bf16x8 pa0, bf16x8 pa1, bf16x8 pa2, bf16x8 pa3) {
  const s16x4 l0 = tr_read<v_rd_off(D0, 0, 0)>(vb), h0 = tr_read<v_rd_off(D0, 0, 1)>(vb), l1 = tr_read<v_rd_off(D0, 1, 0)>(vb), h1 = tr_read<v_rd_off(D0, 1, 1)>(vb);
  const s16x4 l2 = tr_read<v_rd_off(D0, 2, 0)>(vb), h2 = tr_read<v_rd_off(D0, 2, 1)>(vb), l3 = tr_read<v_rd_off(D0, 3, 0)>(vb), h3 = tr_read<v_rd_off(D0, 3, 1)>(vb);
  asm volatile("s_waitcnt lgkmcnt(0)" ::: "memory"); SBAR();
#define PK(L, H) (bf16x8){L[0], L[1], L[2], L[3], H[0], H[1], H[2], H[3]}
  od = __builtin_amdgcn_mfma_f32_32x32x16_bf16(pa0, PK(l0, h0), od, 0, 0, 0);
  od = __builtin_amdgcn_mfma_f32_32x32x16_bf16(pa1, PK(l1, h1), od, 0, 0, 0);
  od = __builtin_amdgcn_mfma_f32_32x32x16_bf16(pa2, PK(l2, h2), od, 0, 0, 0);
  od = __builtin_amdgcn_mfma_f32_32x32x16_bf16(pa3, PK(l3, h3), od, 0, 0, 0);
#undef PK
}
__device__ __forceinline__ void pv_d0(f32x16* o, int vb, bf16x8 pa0, bf16x8 pa1, bf16x8 pa2, bf16x8 pa3) {
  pv_one<0>(o[0], vb, pa0, pa1, pa2, pa3); pv_one<1>(o[1], vb, pa0, pa1, pa2, pa3); pv_one<2>(o[2], vb, pa0, pa1, pa2, pa3); pv_one<3>(o[3], vb, pa0, pa1, pa2, pa3);
}
template <int QH> __device__ __forceinline__ void attn_dense_body(const bf16_t* __restrict__ Qb, const bf16_t* __restrict__ Kh, const bf16_t* __restrict__ Vh,
                                                bf16_t* __restrict__ Ob, int seq, float scale, char* lds, const int tid) {
  constexpr int LDQ = 2048, LDK = 1024, LDO = 1024, SLOT = 32768;
  const float C = scale * 1.4426950408889634f, thr = THR / scale;
  const int wid = __builtin_amdgcn_readfirstlane(tid >> 6), lane = tid & 63, r32 = lane & 31, hi = lane >> 5;
  LAS unsigned char* L3 = (LAS unsigned char*)lds;
  float* ws = (float*)(lds + 4 * SLOT) + wid * 64; float* li_l = ws; float* al_l = ws + 32;
  float m_reg = -1e30f, l_reg = 0; f32x16 o[4] = {}; bf16x8 qr[8];
  const bf16_t* Qw = Qb + (long)(wid * QBLK + r32) * LDQ + hi * 8;
#pragma unroll
  for (int d0 = 0; d0 < 8; ++d0) qr[d0] = *reinterpret_cast<const bf16x8*>(Qw + d0 * 16);
  unsigned ko[2], vo[2];
#pragma unroll
  for (int n = 0; n < 2; ++n) { const int d = (n * 8 + wid) * 1024 + lane * 16;
    { const int r = d >> 8, pos = (d & 255) >> 4, c = pos ^ (r & 7); ko[n] = (unsigned)(r * LDK + c * 8) * 2u; }
    { const int sb = d >> 9, e = d & 511, kk = (sb >> 2) * 8 + (e >> 6), k = (kk & ~0xC) | ((kk & 4) << 1) | ((kk & 8) >> 1), c = (sb & 3) * 32 + ((e & 63) >> 1); vo[n] = (unsigned)(k * LDK + c) * 2u; } }
  const int vrb = (int)(uintptr_t)lds + 16384 + v_rd_base(lane);
#define ADMA(t) do { const size_t tb_ = (size_t)(t) * (size_t)(KVBLK * LDK * 2); const unsigned so_ = (unsigned)((t) & 3) * SLOT + (unsigned)wid * 1024u; \
    _Pragma("unroll") for (int n_ = 0; n_ < 2; ++n_) { \
      __builtin_amdgcn_global_load_lds((const unsigned*)((const char*)Kh + tb_ + ko[n_]), (LAS unsigned*)(L3 + so_ + n_ * 8192), 16, 0, 0); \
      __builtin_amdgcn_global_load_lds((const unsigned*)((const char*)Vh + tb_ + vo[n_]), (LAS unsigned*)(L3 + so_ + 16384 + n_ * 8192), 16, 0, 0); } } while (0)
#define AWAIT(more) do { if (more) asm volatile("s_waitcnt vmcnt(4)" ::: "memory"); else asm volatile("s_waitcnt vmcnt(0)" ::: "memory"); } while (0)
#define ABAR() do { asm volatile("s_waitcnt lgkmcnt(0)" ::: "memory"); __builtin_amdgcn_s_barrier(); asm volatile("" ::: "memory"); } while (0)
#define KSLOT(t) ((const bf16_t*)(lds + ((t) & 3) * SLOT))
#define VSLOT(t) (vrb + ((t) & 3) * SLOT)
#define RESC(a) do { if (__any((a) < 1.f)) { if (hi == 0) al_l[r32] = (a); asm volatile("s_waitcnt lgkmcnt(0)" ::: "memory"); \
    for (int d = 0; d < 4; ++d) for (int r = 0; r < 16; ++r) o[d][r] *= al_l[crow(r, hi)]; } } while (0)
  f32x16 pA0, pA1, pB0, pB1; float mnA, mnB, alA, alB; bf16x8 pa0, pa1, pa2, pa3; const int NT = seq / KVBLK;
  ADMA(0); ADMA(1);
  asm volatile("s_waitcnt vmcnt(4)" ::: "memory"); ABAR();
  if (2 < NT) ADMA(2);
  qkt<QH>(pA0, pA1, KSLOT(0), qr, r32, hi); partialSM(pA0, pA1, m_reg, mnA, alA, C, thr);
  AWAIT(2 < NT); ABAR();
  for (int j = 1; j + 1 < NT; j += 2) {
    if (j + 2 < NT) ADMA(j + 2);
    SBAR(); qkt<QH>(pB0, pB1, KSLOT(j), qr, r32, hi);
    finishSM(pA0, pA1, alA, l_reg, pa0, pa1, pa2, pa3); SBAR();
    pv_d0(o, VSLOT(j - 1), pa0, pa1, pa2, pa3); partialSM(pB0, pB1, m_reg, mnB, alB, C, thr);
    AWAIT(j + 2 < NT); ABAR();
    RESC(alB);
    if (j + 3 < NT) ADMA(j + 3);
    SBAR(); qkt<QH>(pA0, pA1, KSLOT(j + 1), qr, r32, hi);
    finishSM(pB0, pB1, alB, l_reg, pa0, pa1, pa2, pa3); SBAR();
    pv_d0(o, VSLOT(j), pa0, pa1, pa2, pa3); partialSM(pA0, pA1, m_reg, mnA, alA, C, thr);
    AWAIT(j + 3 < NT); ABAR();
    RESC(alA);
  }
  SBAR(); qkt<QH>(pB0, pB1, KSLOT(NT - 1), qr, r32, hi);
  finishSM(pA0, pA1, alA, l_reg, pa0, pa1, pa2, pa3); SBAR();
  pv_d0(o, VSLOT(NT - 2), pa0, pa1, pa2, pa3); partialSM(pB0, pB1, m_reg, mnB, alB, C, thr);
  RESC(alB);
  finishSM(pB0, pB1, alB, l_reg, pa0, pa1, pa2, pa3); SBAR();
  pv_d0(o, VSLOT(NT - 1), pa0, pa1, pa2, pa3);
  if (hi == 0) li_l[r32] = l_reg; asm volatile("s_waitcnt lgkmcnt(0)" ::: "memory");
  float rli[16];
#pragma unroll
  for (int r = 0; r < 16; ++r) rli[r] = __builtin_amdgcn_rcpf(li_l[crow(r, hi)]);
  bf16_t* Ow = Ob + (long)(wid * QBLK) * LDO;
#pragma unroll
  for (int r = 0; r < 16; ++r) { int orow = crow(r, hi);
    for (int d0 = 0; d0 < 4; ++d0) Ow[(long)orow * LDO + d0 * 32 + r32] = f2bf(o[d0][r] * rli[r]); }
#undef ADMA
#undef AWAIT
#undef ABAR
#undef KSLOT
#undef VSLOT
#undef RESC
}
}

template <int DK, int DVS, bool RET>
__device__ __forceinline__ void gla_unit(unsigned char* lds, int b, int h, int dir, int slice,
                                         const bf16_t* __restrict__ Q, const bf16_t* __restrict__ Kp, const bf16_t* __restrict__ V, const float* __restrict__ LF,
                                         bf16_t* __restrict__ Od, float lg, int ldv, int vcol0, const int tid) {
    constexpr int LK = DK + 8, LS = 72, NPG = 512 / DK, PPT = 64 / NPG, VPT = DVS / 8;
    constexpr int NVT = DVS / 16, NKT = DK / 16, TPW = NVT * NKT / 8, WPV = 8 / NVT, NOT = DVS / 32;
    constexpr int LV = DVS + 8;
    unsigned aQD = (unsigned)(uintptr_t)(LAS unsigned char*)lds, aKD = aQD + 64 * LK * 2, aSTB = aKD + 64 * LK * 2, aVI = aSTB + DVS * LK * 2,
             aAT = aVI + 64 * LV * 2, aEL = aAT + 64 * LS * 2, aTOT = aEL + DK * 4;
    asm volatile("" : "+s"(aQD), "+s"(aVI), "+s"(aAT), "+s"(aEL), "+s"(aTOT), "+s"(aKD), "+s"(aSTB));
    LAS bf16_t* QD = (LAS bf16_t*)(uintptr_t)aQD; LAS bf16_t* VI = (LAS bf16_t*)(uintptr_t)aVI; LAS bf16_t* AT = (LAS bf16_t*)(uintptr_t)aAT;
    LAS float* EL = (LAS float*)(uintptr_t)aEL; LAS float* TOT = (LAS float*)(uintptr_t)aTOT;
    LAS bf16_t* KD = (LAS bf16_t*)(uintptr_t)aKD; LAS bf16_t* STB = (LAS bf16_t*)(uintptr_t)aSTB;
    static_assert(2 * 64 * LK * 2 + DVS * LK * 2 + 64 * LV * 2 + 64 * LS * 2 + DK * 4 + 2048 <= 159744, "GLA LDS map");
    const int wid = tid >> 6, lane = tid & 63, l16 = lane & 15, quad = lane >> 4;
    const int tr = wid >> 1, tv = wid / WPV, kt0 = (wid % WPV) * TPW;
    const int vtr = (int)aVI + (8 * quad + (l16 >> 2)) * (LV * 2) + 8 * (lane & 3);
    const int ktr = (int)aKD + (8 * quad + (l16 >> 2)) * (LK * 2) + 8 * (lane & 3);
#define TRR(dst, base, OFF) asm volatile("ds_read_b64_tr_b16 %0, %1 offset:%2" : "=&v"(dst) : "v"(base), "i"(OFF) : "memory")
#define TRFRAG(L, H) (bf16x8){L[0], L[1], L[2], L[3], H[0], H[1], H[2], H[3]}
    f32x4 st[TPW];
#pragma unroll
    for (int t = 0; t < TPW; ++t) st[t] = (f32x4){0.f, 0.f, 0.f, 0.f};
#define GLA_BAR() do { asm volatile("s_waitcnt lgkmcnt(0)" ::: "memory"); __builtin_amdgcn_s_barrier(); asm volatile("" ::: "memory"); } while (0)
    typedef short vvec_t __attribute__((ext_vector_type(VPT)));
    constexpr int NQV = RET ? 4 : 1, NLC = RET ? 1 : PPT;
    bf16x8 qv[NQV], kv[NQV]; float lc[NLC]; bf16_t qr[NLC]; vvec_t vraw;
    const int kx = tid % DK, pg = tid / DK;
    const GAS bf16_t* Qg = (const GAS bf16_t*)Q; const GAS bf16_t* Kg = (const GAS bf16_t*)Kp; const GAS float* LFg = (const GAS float*)LF; const GAS bf16_t* Vg = (const GAS bf16_t*)V;
#define GLA_LOAD(SX) do { const int sx_ = (SX); const int cx_ = dir ? (sx_ < 4 ? 3 - sx_ : 71 - sx_) : sx_; const long Rx_ = (long)b * TB + cx_ * 64; \
        if constexpr (RET) { _Pragma("unroll") for (int j = 0; j < 4; ++j) { const int it = tid + 512 * j, p = it & 63, k0 = (it >> 6) * 8; const long row = Rx_ + (dir ? 63 - p : p); \
                qv[j] = *(const GAS bf16x8*)(Qg + row * 1024 + h * DK + k0); kv[j] = *(const GAS bf16x8*)(Kg + row * 1024 + h * DK + k0); } } \
        else { _Pragma("unroll") for (int i = 0; i < PPT; ++i) { const int p = pg * PPT + i; const long row = Rx_ + (dir ? 63 - p : p); \
                lc[i] = LFg[row * 2048 + dir * 1024 + h * DK + kx]; qr[i] = Qg[row * 1024 + h * DK + kx]; } } \
        } while (0)
    GLA_LOAD(0);
    for (int step = 0; step < 68; ++step) {
        const int cidx = dir ? (step < 4 ? 3 - step : 71 - step) : step;
        const long R0 = (long)b * TB + cidx * 64;
        GLA_BAR();
        {
#pragma unroll
            for (int t = 0; t < TPW; ++t)
#pragma unroll
                for (int j = 0; j < 4; ++j) STB[(tv * 16 + quad * 4 + j) * LK + (kt0 + t) * 16 + l16] = f2bf(st[t][j]);
            { const int p = tid >> 3, vg = tid & 7; const long row = R0 + (dir ? 63 - p : p); vraw = *(const GAS vvec_t*)(Vg + row * ldv + vcol0 + vg * VPT); }
            float bl;
            if constexpr (RET) {
                static_assert(!RET || DK == 256, "retention prep: 64 x 256 = 2048 eight-wide items, four per thread");
                bl = 64.f * lg;
#pragma unroll
                for (int j = 0; j < 4; ++j) { const int it = tid + 512 * j, p = it & 63, k0 = (it >> 6) * 8; const float bb = (float)(p + 1) * lg;
                    const float eq = __expf(bb), ek = __expf(-bb); float a[8], c[8];
#pragma unroll
                    for (int e = 0; e < 8; ++e) { a[e] = bf2f((bf16_t)qv[j][e]) * eq; c[e] = bf2f((bf16_t)kv[j][e]) * ek; }
                    *(LAS u32x4*)(QD + p * LK + k0) = pack8(a); *(LAS u32x4*)(KD + p * LK + k0) = pack8(c); }
            } else {
                float c = 0.f;
#pragma unroll
                for (int i = 0; i < PPT; ++i) c += lc[i];
                TOT[pg * 128 + kx] = c;
                GLA_BAR();
                float off = 0.f; bl = 0.f;
#pragma unroll
                for (int g = 0; g < NPG; ++g) { const float t = TOT[g * 128 + kx]; if (g < pg) off += t; bl += t; }
                float bb = off;
#pragma unroll
                for (int i = 0; i < PPT; ++i) { const int p = pg * PPT + i;
                    const float qf = bf2f(qr[i]), kf = 1.f - __expf(lc[i]); bb += lc[i];
                    QD[p * LK + kx] = f2bf(qf * __expf(bb)); KD[p * LK + kx] = f2bf(kf * __expf(-bb)); }
            }
            if (pg == 0) EL[kx] = __expf(bl);
            { const int p = tid >> 3, vg = tid & 7; *(LAS vvec_t*)(VI + p * LV + vg * VPT) = vraw; }
        }
        if (step + 1 < 68) GLA_LOAD(step + 1);
        GLA_BAR();
        {
            const int tcs = (wid & 1) * 2;
            f32x4 a0 = {0.f, 0.f, 0.f, 0.f}, a1 = {0.f, 0.f, 0.f, 0.f};
#pragma unroll
            for (int kk = 0; kk < DK / 32; ++kk) {
                const bf16x8 af = *(const LAS bf16x8*)(QD + (tr * 16 + l16) * LK + kk * 32 + quad * 8);
                const bf16x8 b0 = *(const LAS bf16x8*)(KD + (tcs * 16 + l16) * LK + kk * 32 + quad * 8);
                const bf16x8 b1 = *(const LAS bf16x8*)(KD + ((tcs + 1) * 16 + l16) * LK + kk * 32 + quad * 8);
                a0 = __builtin_amdgcn_mfma_f32_16x16x32_bf16(af, b0, a0, 0, 0, 0);
                a1 = __builtin_amdgcn_mfma_f32_16x16x32_bf16(af, b1, a1, 0, 0, 0);
                asm volatile("" ::: "memory");
            }
#pragma unroll
            for (int j = 0; j < 4; ++j) { const int p = tr * 16 + quad * 4 + j, s0 = tcs * 16 + l16, s1 = s0 + 16;
                AT[p * LS + s0] = f2bf((s0 <= p) ? a0[j] : 0.f); AT[p * LS + s1] = f2bf((s1 <= p) ? a1[j] : 0.f); }
        }
        GLA_BAR();
#pragma unroll
        for (int t = 0; t < NOT; ++t) { const int tc = (wid & 1) * NOT + t; f32x4 acc = {0.f, 0.f, 0.f, 0.f};
#pragma unroll
            for (int kk = 0; kk < DK / 32; ++kk) {
                const bf16x8 af = *(const LAS bf16x8*)(QD + (tr * 16 + l16) * LK + kk * 32 + quad * 8);
                const bf16x8 bf = *(const LAS bf16x8*)(STB + (tc * 16 + l16) * LK + kk * 32 + quad * 8);
                acc = __builtin_amdgcn_mfma_f32_16x16x32_bf16(af, bf, acc, 0, 0, 0);
                if ((kk & 3) == 3) asm volatile("" ::: "memory"); }
            { s16x4 v00, v01, v10, v11; const int vb = vtr + tc * 32;
                TRR(v00, vb, 0); TRR(v01, vb, 4 * LV * 2); TRR(v10, vb, 32 * LV * 2); TRR(v11, vb, 36 * LV * 2);
                const bf16x8 a0 = *(const LAS bf16x8*)(AT + (tr * 16 + l16) * LS + quad * 8), a1 = *(const LAS bf16x8*)(AT + (tr * 16 + l16) * LS + 32 + quad * 8);
                asm volatile("s_waitcnt lgkmcnt(0)" ::: "memory"); __builtin_amdgcn_sched_barrier(0);
                acc = __builtin_amdgcn_mfma_f32_16x16x32_bf16(a0, TRFRAG(v00, v01), acc, 0, 0, 0);
                acc = __builtin_amdgcn_mfma_f32_16x16x32_bf16(a1, TRFRAG(v10, v11), acc, 0, 0, 0); }
#pragma unroll
            for (int j = 0; j < 4; ++j) { const int p = tr * 16 + quad * 4 + j; const long row = R0 + (dir ? 63 - p : p);
                ((GAS bf16_t*)Od)[row * ldv + vcol0 + tc * 16 + l16] = f2bf(acc[j]); }
        }
        { s16x4 a00, a01, a10, a11; const int vb = vtr + tv * 32;
            TRR(a00, vb, 0); TRR(a01, vb, 4 * LV * 2); TRR(a10, vb, 32 * LV * 2); TRR(a11, vb, 36 * LV * 2);
#pragma unroll
            for (int t0 = 0; t0 < TPW; t0 += 2) {
                s16x4 b[2][4];
#pragma unroll
                for (int u = 0; u < 2; ++u) { const int kb = ktr + (kt0 + t0 + u) * 32;
                    TRR(b[u][0], kb, 0); TRR(b[u][1], kb, 4 * LK * 2); TRR(b[u][2], kb, 32 * LK * 2); TRR(b[u][3], kb, 36 * LK * 2); }
                asm volatile("s_waitcnt lgkmcnt(0)" ::: "memory"); __builtin_amdgcn_sched_barrier(0);
#pragma unroll
                for (int u = 0; u < 2; ++u) { const int t = t0 + u;
                    st[t] = __builtin_amdgcn_mfma_f32_16x16x32_bf16(TRFRAG(a00, a01), TRFRAG(b[u][0], b[u][1]), st[t], 0, 0, 0);
                    st[t] = __builtin_amdgcn_mfma_f32_16x16x32_bf16(TRFRAG(a10, a11), TRFRAG(b[u][2], b[u][3]), st[t], 0, 0, 0); }
            }
#pragma unroll
            for (int t = 0; t < TPW; ++t) st[t] = st[t] * EL[(kt0 + t) * 16 + l16];
        }
    }
    __syncthreads();
#undef TRR
#undef TRFRAG
#undef GLA_BAR
#undef GLA_LOAD
}

constexpr int LDS_BYTES = 160000;
struct Params { const float* in[26]; float* out; unsigned char* ws; };

__device__ __forceinline__ void sincos_cw(float x, float& s, float& c) {
    const float n = rintf(x * 0.6366197723675814f);
    float r = fmaf(-n, 1.5703125f, x); r = fmaf(-n, 4.837512969970703125e-4f, r); r = fmaf(-n, 7.54978995489188216e-8f, r);
    const float z = r * r;
    const float sp = r + r * z * (-1.6666654611e-1f + z * (8.3321608736e-3f + z * (-1.9515295891e-4f)));
    const float cp = 1.f - 0.5f * z + z * z * (4.166664568298827e-2f + z * (-1.388731625493765e-3f + z * 2.443315711809948e-5f));
    const int q = ((int)n) & 3;
    s = (q == 0) ? sp : (q == 1) ? cp : (q == 2) ? -sp : -cp;
    c = (q == 0) ? cp : (q == 1) ? -sp : (q == 2) ? -cp : sp;
}

__device__ __forceinline__ int permrow(int pt, int n) {
    if (pt == 1) { return n < FF ? (n / 128) * 256 + (n % 128) : ((n - FF) / 128) * 256 + 128 + ((n - FF) % 128); }
    if (pt == 2) { if (n >= 2048) return n; const int tile = n >> 8, ut = (n >> 6) & 3, w = n & 63; return tile * 256 + ((w >> 4) & 1) * 128 + ut * 32 + (w >> 5) * 16 + (w & 15); }
    if (pt == 3) { if (n >= 2048) return n; const int tile = n >> 8, w = n & 255; return tile * 256 + ((w >> 6) & 1) * 128 + (w >> 7) * 64 + (w & 63); }
    return n;
}
__device__ __forceinline__ void transpose_item(const float* __restrict__ W, int K, int N, bf16_t* __restrict__ WT, int pt, float* scr, int item, int lane) {
    const int nblk = N / 32, kb = item / nblk, nb = item % nblk, k0 = 64 * kb, n0 = 32 * nb;
#pragma unroll 8
    for (int i = 0; i < 32; ++i) { const int kk = 2 * i + (lane >> 5); scr[kk * 33 + (lane & 31)] = __builtin_nontemporal_load(&W[(size_t)(k0 + kk) * N + n0 + (lane & 31)]); }
    asm volatile("s_waitcnt lgkmcnt(0)" ::: "memory");
    const int c = lane & 7;
#pragma unroll
    for (int j = 0; j < 4; ++j) { const int n = (lane >> 3) + 8 * j; const float* s = scr + (8 * c) * 33 + n;
        u32x4 o; o.x = cvt_pk_bf16(s[0 * 33], s[1 * 33]); o.y = cvt_pk_bf16(s[2 * 33], s[3 * 33]); o.z = cvt_pk_bf16(s[4 * 33], s[5 * 33]); o.w = cvt_pk_bf16(s[6 * 33], s[7 * 33]);
        *(u32x4*)(WT + (size_t)permrow(pt, n0 + n) * K + k0 + 8 * c) = o; }
    asm volatile("s_waitcnt lgkmcnt(0)" ::: "memory");
}

#define XB_XCNT(j)  (64 + 64 * (j))
#define XB_XSUB(j)  (64 * 17 + 64 * (j))
#define XB_XGEN(j)  (64 * 33 + 64 * (j))
#define XB_TOP      (64 * 49)
#define XB_TOPGEN   (64 * 50)
#define XB_WORDS    (64 * 51)
__device__ __forceinline__ unsigned xb_add(unsigned* p, unsigned v) { return __hip_atomic_fetch_add(p, v, __ATOMIC_RELAXED, __HIP_MEMORY_SCOPE_AGENT); }
__device__ __forceinline__ unsigned xb_xcc_id() { return (unsigned)__builtin_amdgcn_s_getreg((3 << 11) | 20) & 0xFu; }
__device__ __forceinline__ void grid_bar(unsigned* bar, volatile LAS unsigned* st, int tid) {
    asm volatile("s_waitcnt vmcnt(0) lgkmcnt(0)" ::: "memory");
    __syncthreads();
    if (tid == 0) {
        const unsigned x = xb_xcc_id();
        unsigned nloc = st[0], nx = st[1];
        if (nloc == 0u) {
            const unsigned Gt = gridDim.x;
            for (;;) { unsigned sum = 0u, cnt = 0u, mine = 0u;
#pragma unroll
                for (unsigned j = 0; j < 16; ++j) { const unsigned c = xb_add(&bar[XB_XCNT(j)], 0u); sum += c; cnt += (c > 0u) ? 1u : 0u; mine = (j == x) ? c : mine; }
                if (sum == Gt) { nloc = mine; nx = cnt; break; }
                __builtin_amdgcn_s_sleep(2); }
            st[0] = nloc; st[1] = nx;
        }
        const unsigned old = xb_add(&bar[XB_XSUB(x)], 1u), gen = old / nloc;
        if (old + 1u == (gen + 1u) * nloc) {
            __builtin_amdgcn_fence(__ATOMIC_RELEASE, "agent");
            asm volatile("s_waitcnt vmcnt(0)" ::: "memory");
            const unsigned og = xb_add(&bar[XB_TOP], 1u), tg = og / nx;
            if (og + 1u == (tg + 1u) * nx) xb_add(&bar[XB_TOPGEN], 1u);
            else while (xb_add(&bar[XB_TOPGEN], 0u) == tg) __builtin_amdgcn_s_sleep(2);
            __builtin_amdgcn_fence(__ATOMIC_ACQUIRE, "agent");
            xb_add(&bar[XB_XGEN(x)], 1u);
            asm volatile("s_waitcnt vmcnt(0)" ::: "memory");
        } else {
            while (xb_add(&bar[XB_XGEN(x)], 0u) == gen) __builtin_amdgcn_s_sleep(2);
            __builtin_amdgcn_fence(__ATOMIC_ACQUIRE, "agent");
            asm volatile("s_waitcnt vmcnt(0)" ::: "memory");
        }
    }
    __syncthreads();
}
__device__ __forceinline__ void norm_row(const f32x4 (&v)[4], const float* __restrict__ sh, const float* __restrict__ sc, bf16_t* __restrict__ orow, int lane) {
    float s = 0.f;
#pragma unroll
    for (int j = 0; j < 4; ++j) s += (v[j].x * v[j].x + v[j].y * v[j].y) + (v[j].z * v[j].z + v[j].w * v[j].w);
    const float rinv = rsqrtf(wave_sum(s) * (1.f / DM) + EPS);
    u32x2* o8 = (u32x2*)orow + lane;
#pragma unroll
    for (int j = 0; j < 4; ++j) { const f32x4 a = *((const f32x4*)sh + lane + 64 * j), b = *((const f32x4*)sc + lane + 64 * j);
        const f32x4 y = v[j] * rinv * (b + 1.f) + a; u32x2 w; w.x = cvt_pk_bf16(y.x, y.y); w.y = cvt_pk_bf16(y.z, y.w); o8[64 * j] = w; }
}

#define CONVERT_LAYER(L_) do { \
                float* scr = (float*)lds + wave * (64 * 33); \
                const float* win; const float* wout; int nin, kout, ptin; \
                if ((L_) == 0) { win = P.in[10]; wout = P.in[11]; nin = 3072; kout = 1024; ptin = 2; } \
                else if ((L_) == 1) { win = P.in[14]; wout = P.in[15]; nin = 6144; kout = 2048; ptin = 3; } \
                else if ((L_) == 2) { win = P.in[17]; wout = P.in[18]; nin = 5120; kout = 1024; ptin = 0; } \
                else { win = P.in[21]; wout = P.in[22]; nin = 1536; kout = 1024; ptin = 0; } \
                const int I13 = (DM / 64) * (2 * FF / 32), I2 = (FF / 64) * (DM / 32), IIN = (DM / 64) * (nin / 32), IOUT = (kout / 64) * (DM / 32); \
                const int NIT = 2 * I13 + 2 * I2 + IIN + IOUT; \
                for (int it = gw; it < NIT; it += NGW) { \
                    int r = it; const float* W; int K, N, pt; bf16_t* WT; \
                    if (r < 2 * I13) { const int sel = r >= I13; r -= sel * I13; W = P.in[sel ? 8 : 6] + (size_t)(L_) * DM * 2 * FF; K = DM; N = 2 * FF; pt = 1; WT = (bf16_t*)(ws + (sel ? WS_W13B : WS_W13A)); } \
                    else if ((r -= 2 * I13) < 2 * I2) { const int sel = r >= I2; r -= sel * I2; W = P.in[sel ? 9 : 7] + (size_t)(L_) * FF * DM; K = FF; N = DM; pt = 0; WT = (bf16_t*)(ws + (sel ? WS_W2B : WS_W2A)); } \
                    else if ((r -= 2 * I2) < IIN) { W = win; K = DM; N = nin; pt = ptin; WT = (bf16_t*)(ws + WS_WIN); } \
                    else { r -= IIN; W = wout; K = kout; N = DM; pt = 0; WT = (bf16_t*)(ws + WS_WOUT); } \
                    transpose_item(W, K, N, WT, pt, scr, r, lane); \
                } } while (0)

__global__ void __launch_bounds__(512) mk_fwd(Params P) {
    extern __shared__ __attribute__((aligned(16))) unsigned char lds[];
    cg::grid_group grid = cg::this_grid();
    const int G = gridDim.x;
    unsigned bar_target = 0;
#define GRID_SYNC() do { if (ph == 0) { grid.sync(); if (threadIdx.x == 0) (void)xb_add((unsigned*)(P.ws + WS_XB) + XB_XCNT(xb_xcc_id()), 1u); } else grid_bar((unsigned*)(P.ws + WS_XB), (volatile LAS unsigned*)((LAS unsigned char*)lds + LDS_BYTES - 16), threadIdx.x); } while (0)

    constexpr int NPH = 2 + 44 + 1;
    for (int ph = 0; ph < NPH; ++ph) {
        int tid = threadIdx.x; asm volatile("" : "+v"(tid));
        int bid = blockIdx.x; asm volatile("" : "+s"(bid));
        unsigned char* ws = P.ws; asm volatile("" : "+s"(ws));
        const int lane = tid & 63, wave = __builtin_amdgcn_readfirstlane(tid >> 6), gw = bid * 8 + wave, NGW = G * 8;
        float* const H = (float*)(ws + WS_H); bf16_t* const XN = (bf16_t*)(ws + WS_XN); float* const MOD = (float*)(ws + WS_MOD); float* const MODP = (float*)(ws + WS_MODP);
        float* const LBV = (float*)(ws + WS_LBV); float* const ROPE = (float*)(ws + WS_ROPE);
        unsigned char* const BIG = ws + WS_BIG;
        const int l = (ph - 2) / 11, step = ph < 2 ? -1 : (ph == NPH - 1 ? -2 : (ph - 2) % 11);
        if (ph == 0) {
            const f32x4* x4 = (const f32x4*)P.in[0]; const f32x4* c4 = (const f32x4*)P.in[2]; f32x4* h4 = (f32x4*)H;
            for (size_t i = (size_t)bid * 512 + tid; i < (size_t)M * 256; i += (size_t)G * 512) {
                const int row = (int)(i >> 8), c = (int)(i & 255), bi = row / TB, rr = row - bi * TB;
                h4[i] = rr < CTXL ? c4[((size_t)bi * CTXL + rr) * 256 + c] : x4[((size_t)bi * SEQ + (rr - CTXL)) * 256 + c];
            }
            for (int e = bid * 512 + tid; e < 64 * 112; e += G * 512) {
                int pos, j, nq; size_t off;
                if (e < 64 * 16) { nq = 16; pos = e / 16; j = e % 16; off = ROPE16 + (size_t)e * 2; }
                else if (e < 64 * 48) { const int q = e - 64 * 16; nq = 32; pos = q / 32; j = q % 32; off = ROPE32 + (size_t)q * 2; }
                else { const int q = e - 64 * 48; nq = 64; pos = q / 64; j = q % 64; off = ROPE64 + (size_t)q * 2; }
                const float inv = exp2f(-(float)j / (float)nq * 13.287712379549449f);
                float sn, cs; sincos_cw((float)pos * inv, sn, cs);
                ROPE[off] = cs; ROPE[off + 1] = sn;
            }
            if (bid == 0) for (int i = tid; i < XB_WORDS; i += 512) __hip_atomic_store((unsigned*)(ws + WS_XB) + i, 0u, __ATOMIC_RELAXED, __HIP_MEMORY_SCOPE_AGENT);
            if (tid < 4) ((volatile LAS unsigned*)((LAS unsigned char*)lds + LDS_BYTES - 16))[tid] = 0u;
            float* cond = (float*)lds; float* red = cond + 5 * 1024;
            for (int i = tid; i < 5120; i += 512) { const int r = i >> 10, k = i & 1023; const float x = r < 4 ? P.in[1][r * 1024 + k] : P.in[3][k]; cond[i] = siluf(x); }
            __syncthreads();
            for (int unit = bid; unit < 1152; unit += G) {
                const int ks = unit & 7, cgp = (unit >> 3) % 36, ll = unit / 288;
                const float* W = P.in[4] + (size_t)ll * DM * NMOD + cgp * 256 + lane * 4;
                const int kbase = ks * 128 + wave * 16;
                f32x4 a[5];
#pragma unroll
                for (int r = 0; r < 5; ++r) a[r] = (f32x4){0.f, 0.f, 0.f, 0.f};
#pragma unroll 4
                for (int kk = 0; kk < 16; ++kk) { const int k = kbase + kk; const f32x4 w = __builtin_nontemporal_load((const f32x4*)(W + (size_t)k * NMOD));
#pragma unroll
                    for (int r = 0; r < 5; ++r) a[r] += w * cond[r * 1024 + k]; }
#pragma unroll
                for (int r = 0; r < 5; ++r) *(f32x4*)(red + (wave * 5 + r) * 256 + lane * 4) = a[r];
                __syncthreads();
                for (int o = tid; o < 1280; o += 512) { const int r = o >> 8, cc = o & 255; float sum = 0.f;
#pragma unroll
                    for (int w = 0; w < 8; ++w) sum += red[(w * 5 + r) * 256 + cc];
                    MODP[(size_t)((ks * 4 + ll) * 5 + r) * NMOD + cgp * 256 + cc] = sum; }
                __syncthreads();
            }
        } else if (ph == 1) {
            for (int i = bid * 512 + tid; i < 4 * 5 * NMOD; i += G * 512) { const int ll = i / (5 * NMOD), n = i % NMOD; float sum = P.in[5][ll * NMOD + n];
#pragma unroll
                for (int ks = 0; ks < 8; ++ks) sum += MODP[(size_t)ks * (4 * 5 * NMOD) + i];
                MOD[i] = sum; }
            for (int c = bid * 512 + tid; c < 1024; c += G * 512) { const float* lb = P.in[19]; const float a0 = lb[c], a1 = lb[1024 + c], a2 = lb[2048 + c], a3 = lb[3072 + c];
                const float mx = fmaxf(fmaxf(a0, a1), fmaxf(a2, a3)); const float e0 = __expf(a0 - mx), e1 = __expf(a1 - mx), e2 = __expf(a2 - mx), e3 = __expf(a3 - mx);
                LBV[c] = (e1 + e2) / (e0 + e1 + e2 + e3); }
        } else if (step == -2) {
            for (int r = gw; r < NB * SEQ; r += NGW) { const int bi = r >> 12, t = r & 4095; const size_t row = (size_t)bi * TB + CTXL + t;
                const f32x4* xr = (const f32x4*)(H + row * DM) + lane; f32x4 v[4]; float s = 0.f;
#pragma unroll
                for (int j = 0; j < 4; ++j) { v[j] = xr[64 * j]; s += (v[j].x * v[j].x + v[j].y * v[j].y) + (v[j].z * v[j].z + v[j].w * v[j].w); }
                const float rinv = rsqrtf(wave_sum(s) * (1.f / DM) + EPS);
                f32x4* op = (f32x4*)(P.out + (size_t)r * DM) + lane; const f32x4* gp = (const f32x4*)P.in[25] + lane;
#pragma unroll
                for (int j = 0; j < 4; ++j) op[64 * j] = v[j] * rinv * gp[64 * j]; }
        } else if (step == 0 || step == 3 || step == 8) {
            const float* modn = MOD + (size_t)l * 5 * NMOD + step * DM - (step == 8 ? 2 * DM : 0);
            if (step == 0 && (wave & 1)) CONVERT_LAYER(l);
            const int ns = step == 0 ? (l == 0 ? 0 : 11) : step == 3 ? 11 : (l == 3 ? 0 : l == 1 ? 8 : 4);
            const float* PART = (const float*)(BIG + 3 * U1);
            for (int row = gw; row < M; row += NGW) {
                const int bi = row / TB, rr = row - bi * TB, mrow = rr < CTXL ? 4 : bi;
                const float* sh = modn + (size_t)mrow * NMOD;
                f32x4* hr = (f32x4*)(H + (size_t)row * DM) + lane; f32x4 v[4];
#pragma unroll
                for (int j = 0; j < 4; ++j) v[j] = hr[64 * j];
                if (ns && rr < CTXL) {
                    for (int sp = 0; sp < ns; ++sp) { const f32x4* pr = (const f32x4*)(PART + ((size_t)sp * 1024 + bi * 256 + rr) * DM) + lane;
#pragma unroll
                        for (int j = 0; j < 4; ++j) v[j] += pr[64 * j]; }
#pragma unroll
                    for (int j = 0; j < 4; ++j) hr[64 * j] = v[j];
                }
                norm_row(v, sh, sh + DM, XN + (size_t)row * DM, lane);
            }
            if (step == 0 && !(wave & 1)) CONVERT_LAYER(l);
        } else if (step == 1 || step == 2 || step == 4 || step == 7 || step == 9 || step == 10) {
            pg8::EpiAll E{}; pg8::Gemm g{}; int nN, lat = 0, resid = 0; E.ws = ws;
            if (step == 1 || step == 9) { E.kind = pg8::K_SWIGLU; g.A = XN; g.Bt = (const bf16_t*)(ws + (step == 1 ? WS_W13A : WS_W13B)); g.K = DM; nN = 22; lat = (step == 9 && l == 3); }
            else if (step == 2 || step == 10) { E.kind = pg8::K_RESID; E.aux = l * 16 + (step == 2 ? 2 : 8); g.A = (const bf16_t*)BIG; g.Bt = (const bf16_t*)(ws + (step == 2 ? WS_W2A : WS_W2B)); g.K = FF; nN = 4; lat = 1; resid = (step == 10 && l == 3) ? 1 : 2; }
            else if (step == 7) { E.kind = pg8::K_RESID; E.aux = l * 16 + 5; g.Bt = (const bf16_t*)(ws + WS_WOUT); nN = 4; lat = 1; resid = (l == 3) ? 1 : 2;
                g.A = (const bf16_t*)(BIG + (l == 0 ? 6 * U1 : l == 1 ? 4 * U1 : l == 2 ? 9 * U1 : 7 * U1)); g.K = (l == 1) ? 2048 : DM; }
            else { g.A = XN; g.Bt = (const bf16_t*)(ws + WS_WIN); g.K = DM;
                if (l == 0) { E.kind = pg8::K_DIFF; nN = 12; } else if (l == 1) { E.kind = pg8::K_RET; nN = 24; } else if (l == 2) { E.kind = pg8::K_HGRN; nN = 20; } else { E.kind = pg8::K_GQA; nN = 6; } }
            const int npass = resid == 2 ? 2 : 1;
            for (int pass = 0; pass < npass; ++pass) {
                pg8::Order S; g.nt = pass ? 4 : g.K / 64; if (pass) E.kind = pg8::K_PART;
                S.init(lat ? 64 : 68, nN, G, bid, pass ? 2 : lat, g.K / 256);
                pg8::gemm_phase<pg8::EpiAll, pg8::Order>((LAS unsigned char*)lds, g, S, E, tid);
            }
        } else if ((step == 5 && l == 0) || (step == 6 && l == 3)) {
            const bool df = (l == 0);
            const bf16_t* Qp = (const bf16_t*)(BIG + (df ? 0 : 3 * U1)); const bf16_t* Kp = (const bf16_t*)(BIG + (df ? 2 * U1 : 5 * U1)); const bf16_t* Vp = (const bf16_t*)(BIG + (df ? 3 * U1 : 6 * U1));
            bf16_t* Op = (bf16_t*)(BIG + (df ? 4 * U1 : 7 * U1));
            const int nun = df ? 1088 : 512; const float scale = df ? 1.0f : 0.08838834764831845f;
            for (int L = bid; L < nun; L += G) {
                int bq, hm, qb, seq, kvh;
                if (df) { if (L < 1024) { qb = (L & 15) + 1; hm = (L >> 4) & 15; bq = L >> 8; seq = TB; } else { const int L2 = L - 1024; hm = L2 & 15; bq = L2 >> 4; qb = 0; seq = CTXL; } kvh = hm >> 1; }
                else { qb = (L & 15) + 1; hm = (L >> 4) & 7; bq = L >> 7; seq = TB; kvh = hm >> 2; }
                const size_t r0 = (size_t)bq * TB + qb * 256;
                const size_t qoff = r0 * 2048 + hm * 128, koff = (size_t)bq * TB * 1024 + kvh * 128, ooff = (size_t)(hm >> 3) * ((size_t)M * 1024) + r0 * 1024 + (hm & 7) * 128;
                if (!df) att::attn_dense_body<0>(Qp + qoff, Kp + koff, Vp + koff, Op + ooff, seq, scale, (char*)lds, tid);
                else if (hm & 1) att::attn_dense_body<2>(Qp + qoff, Kp + koff, Vp + koff, Op + ooff, seq, scale, (char*)lds, tid);
                else att::attn_dense_body<1>(Qp + qoff, Kp + koff, Vp + koff, Op + ooff, seq, scale, (char*)lds, tid);
                __syncthreads();
            }
        } else if (step == 6 && l == 0) {
            const bf16_t* Ob = (const bf16_t*)(BIG + 4 * U1); bf16_t* A2b = (bf16_t*)(BIG + 6 * U1);
            const float* lam = P.in[12]; const float la = lam[lane] * lam[64 + lane], lb2 = lam[128 + lane] * lam[192 + lane];
            const float lam_full = __expf(wave_sum(la)) - __expf(wave_sum(lb2)) + 0.2f;
            const int hh = lane >> 3, v0 = (lane & 7) * 16;
            for (int row = gw; row < M; row += NGW) {
                const bf16_t* p0 = Ob + (size_t)(hh >> 2) * ((size_t)M * 1024) + (size_t)row * 1024 + ((2 * hh) & 7) * 128 + v0; const bf16_t* p1 = p0 + 128;
                const bf16x8 a0 = *(const bf16x8*)p0, a1 = *(const bf16x8*)(p0 + 8), b0 = *(const bf16x8*)p1, b1 = *(const bf16x8*)(p1 + 8);
                float o[16]; float s = 0.f;
#pragma unroll
                for (int e = 0; e < 8; ++e) { o[e] = bf2f((bf16_t)a0[e]) - lam_full * bf2f((bf16_t)b0[e]); o[8 + e] = bf2f((bf16_t)a1[e]) - lam_full * bf2f((bf16_t)b1[e]); }
#pragma unroll
                for (int e = 0; e < 16; ++e) s += o[e] * o[e];
                s += __shfl_xor(s, 1); s += __shfl_xor(s, 2); s += __shfl_xor(s, 4);
                const float rinv = rsqrtf(s * (1.f / 128.f) + EPS) * 0.8f;
#pragma unroll
                for (int e = 0; e < 16; ++e) o[e] = o[e] * rinv * P.in[13][v0 + e];
                bf16_t* dp = A2b + (size_t)row * 1024 + hh * 128 + v0;
                *(u32x4*)dp = pack8(o); *(u32x4*)(dp + 8) = pack8(o + 8);
            }
        } else if (step == 5 && l == 1) {
            const bf16_t* Qb = (const bf16_t*)BIG; const bf16_t* Kb = (const bf16_t*)(BIG + U1); const bf16_t* Vb = (const bf16_t*)(BIG + 2 * U1); bf16_t* OF = (bf16_t*)(BIG + 6 * U1); bf16_t* OB = (bf16_t*)(BIG + 8 * U1);
            for (int L = bid; L < 256; L += G) {
                const int slice = L & 7, dir = (L >> 3) & 1, hh = (L >> 4) & 3, bq = L >> 6;
                const float lg = __logf(1.f - exp2f(-P.in[16][dir * 4 + hh]));
                gla_unit<256, 64, true>(lds, bq, hh, dir, slice, Qb, Kb, Vb, nullptr, dir ? OB : OF, lg, 2048, hh * 512 + slice * 64, tid);
            }
        } else if (step == 6 && l == 1) {
            bf16_t* Gb = (bf16_t*)(BIG + 4 * U1); const bf16_t* OF = (const bf16_t*)(BIG + 6 * U1); const bf16_t* OB = (const bf16_t*)(BIG + 8 * U1);
            for (int row = gw; row < M; row += NGW) {
#pragma unroll
                for (int hh = 0; hh < 4; ++hh) { const size_t off = (size_t)row * 2048 + hh * 512 + lane * 8;
                    const bf16x8 a = *(const bf16x8*)(OF + off), b = *(const bf16x8*)(OB + off), gt = *(const bf16x8*)(Gb + off);
                    float o[8]; float s = 0.f;
#pragma unroll
                    for (int e = 0; e < 8; ++e) { o[e] = bf2f((bf16_t)a[e]) + bf2f((bf16_t)b[e]); s += o[e] * o[e]; }
                    const float rinv = rsqrtf(wave_sum(s) * (1.f / 512.f) + EPS);
#pragma unroll
                    for (int e = 0; e < 8; ++e) o[e] = o[e] * rinv * bf2f((bf16_t)gt[e]);
                    *(u32x4*)(Gb + off) = pack8(o); }
            }
        } else if (step == 5 && l == 2) {
            const bf16_t* Qb = (const bf16_t*)BIG; const bf16_t* Vb = (const bf16_t*)(BIG + U1); const float* LF = (const float*)(BIG + 3 * U1); bf16_t* OF = (bf16_t*)(BIG + 7 * U1); bf16_t* OB = (bf16_t*)(BIG + 8 * U1);
            for (int L = bid; L < 256; L += G) {
                const int slice = L & 3, dir = (L >> 2) & 1, hh = (L >> 3) & 7, bq = L >> 6;
                gla_unit<128, 32, false>(lds, bq, hh, dir, slice, Qb, nullptr, Vb, LF, dir ? OB : OF, 0.f, 1024, hh * 128 + slice * 32, tid);
            }
        } else if (step == 6 && l == 2) {
            const bf16_t* Gb = (const bf16_t*)(BIG + 2 * U1); const bf16_t* OF = (const bf16_t*)(BIG + 7 * U1); const bf16_t* OB = (const bf16_t*)(BIG + 8 * U1); bf16_t* A2b = (bf16_t*)(BIG + 9 * U1);
            const int v0 = (lane & 7) * 16;
            for (int row = gw; row < M; row += NGW) { const size_t off = (size_t)row * 1024 + lane * 16;
                const bf16x8 a0 = *(const bf16x8*)(OF + off), a1 = *(const bf16x8*)(OF + off + 8), b0 = *(const bf16x8*)(OB + off), b1 = *(const bf16x8*)(OB + off + 8);
                const bf16x8 g0 = *(const bf16x8*)(Gb + off), g1 = *(const bf16x8*)(Gb + off + 8);
                float o[16]; float s = 0.f;
#pragma unroll
                for (int e = 0; e < 8; ++e) { o[e] = bf2f((bf16_t)a0[e]) + bf2f((bf16_t)b0[e]); o[8 + e] = bf2f((bf16_t)a1[e]) + bf2f((bf16_t)b1[e]); }
#pragma unroll
                for (int e = 0; e < 16; ++e) s += o[e] * o[e];
                s += __shfl_xor(s, 1); s += __shfl_xor(s, 2); s += __shfl_xor(s, 4);
                const float rinv = rsqrtf(s * (1.f / 128.f) + EPS);
#pragma unroll
                for (int e = 0; e < 8; ++e) { o[e] = o[e] * rinv * P.in[20][v0 + e] * bf2f((bf16_t)g0[e]); o[8 + e] = o[8 + e] * rinv * P.in[20][v0 + 8 + e] * bf2f((bf16_t)g1[e]); }
                *(u32x4*)(A2b + off) = pack8(o); *(u32x4*)(A2b + off + 8) = pack8(o + 8); }
        } else if (step == 5 && l == 3) {
            const float* QKR = (const float*)BIG; bf16_t* Qb = (bf16_t*)(BIG + 3 * U1); bf16_t* Kb = (bf16_t*)(BIG + 5 * U1);
            const float* tab = ROPE + ROPE32; const int jj = lane & 31;
            const float gq0 = P.in[23][lane], gq1 = P.in[23][lane + 64], gk0 = P.in[24][lane], gk1 = P.in[24][lane + 64];
            for (int it = gw; it < M * 10; it += NGW) { const int row = it / 10, slot = it - row * 10; const int bi = row / TB, rr = row - bi * TB;
                const float* src = QKR + (size_t)row * 1280 + slot * 128;
                float x0 = src[lane], x1 = src[lane + 64];
                const float rinv = rsqrtf(wave_sum(x0 * x0 + x1 * x1) * (1.f / 128.f) + EPS);
                x0 = x0 * rinv * (slot < 8 ? gq0 : gk0); x1 = x1 * rinv * (slot < 8 ? gq1 : gk1);
                if (rr >= CTXL) { const int t = rr - CTXL, pr = t >> 6, pc = t & 63;
                    const float c0 = tab[(pr * 32 + jj) * 2], s0 = tab[(pr * 32 + jj) * 2 + 1], c1 = tab[(pc * 32 + jj) * 2], s1 = tab[(pc * 32 + jj) * 2 + 1];
                    const float y0 = __shfl_xor(x0, 32), y1 = __shfl_xor(x1, 32);
                    x0 = lane < 32 ? x0 * c0 - y0 * s0 : x0 * c0 + y0 * s0;
                    x1 = lane < 32 ? x1 * c1 - y1 * s1 : x1 * c1 + y1 * s1; }
                bf16_t* dst = slot < 8 ? Qb + (size_t)row * 2048 + slot * 128 : Kb + (size_t)row * 1024 + (slot - 8) * 128;
                dst[lane] = f2bf(x0); dst[lane + 64] = f2bf(x1); }
        }
        if (ph + 1 < NPH) GRID_SYNC();
    }
}

extern "C" void kernel_launch(void* const* d_in, const int* in_sizes, int n_in, void* d_out, int out_size, void* d_ws, size_t ws_size, hipStream_t stream) {
    static int grid = 0;
    if (grid == 0) {
        if (n_in != 26 || out_size != NB * SEQ * DM || ws_size < WS_END) { fprintf(stderr, "kernel_launch: unexpected shapes (n_in %d out %d ws %zu need %zu)\n", n_in, out_size, ws_size, (size_t)WS_END); grid = -1; return; }
        int dev = 0, cus = 0, per_cu = 0;
        if (hipGetDevice(&dev) != hipSuccess || hipDeviceGetAttribute(&cus, hipDeviceAttributeMultiprocessorCount, dev) != hipSuccess) { grid = -1; return; }
        if (hipFuncSetAttribute((const void*)mk_fwd, hipFuncAttributeMaxDynamicSharedMemorySize, LDS_BYTES) != hipSuccess) { fprintf(stderr, "kernel_launch: hipFuncSetAttribute failed\n"); grid = -1; return; }
        if (hipOccupancyMaxActiveBlocksPerMultiprocessor(&per_cu, (const void*)mk_fwd, 512, LDS_BYTES) != hipSuccess || per_cu < 1) { fprintf(stderr, "kernel_launch: occupancy query says %d\n", per_cu); per_cu = 1; }
        (void)hipGetLastError();
        grid = cus;
    }
    if (grid < 0) return;
    Params p{};
    for (int i = 0; i < 26; ++i) p.in[i] = (const float*)d_in[i];
    p.out = (float*)d_out; p.ws = (unsigned char*)d_ws;
    void* args[] = {&p};
    hipError_t e = hipLaunchCooperativeKernel((const void*)mk_fwd, dim3(grid), dim3(512), args, LDS_BYTES, stream);
    if (e != hipSuccess) fprintf(stderr, "cooperative launch failed: %s (grid %d)\n", hipGetErrorString(e), grid);
}
```
